# Optimizing an MI355X kernel written in HIP

```python
import math
import jax, jax.numpy as jnp
from jax import lax
import numpy as np

D_MODEL = 1024
BATCH = 1
SEQ = 16384
DEPTH = 4

N_META = 16
RMS_EPS = 1e-6
D_FF = 4 * D_MODEL
N_EVEN = (DEPTH + 1) // 2
N_ODD = DEPTH // 2
RWKV_HEAD = 64
RWKV_WIDTH = D_MODEL // 2
RWKV_HEADS = RWKV_WIDTH // RWKV_HEAD
DECAY_RANK = 64
ICLR_RANK = 64
GATE_RANK = 128
GN_EPS = RWKV_HEAD * 1e-5
POOL_WIDTH = D_MODEL - RWKV_WIDTH
POOL_WINDOWS = (2, 4, 8, 16)
POOL_GROUPS = len(POOL_WINDOWS)
POOL_GROUP_W = POOL_WIDTH // POOL_GROUPS
SHIFT_WIDTH = 3 * RWKV_WIDTH + DECAY_RANK + ICLR_RANK + GATE_RANK
EVEN_IN = SHIFT_WIDTH + POOL_WIDTH
RWKV_SPLITS = (RWKV_WIDTH, 2 * RWKV_WIDTH, 3 * RWKV_WIDTH,
               3 * RWKV_WIDTH + DECAY_RANK, 3 * RWKV_WIDTH + DECAY_RANK + ICLR_RANK)
DIFF_HEADS = 8
DIFF_HEAD = D_MODEL // (2 * DIFF_HEADS)
DIFF_IN = 3 * D_MODEL
SUBLN_EPS = 1e-5
ROPE_THETA = 10000.0
Q_BLOCK = 128

kernel_name = 'hybrid_rwkv7_pool_diffattn'


def rmsnorm(t, g, eps=RMS_EPS):
    tf = t.astype(jnp.float32)
    tf = tf * lax.rsqrt(jnp.mean(tf * tf, axis=-1, keepdims=True) + eps)
    return (tf * g.astype(jnp.float32)).astype(t.dtype)


def rope_tables(length):
    pos = jnp.arange(length, dtype=jnp.float32)
    inv = ROPE_THETA ** (-jnp.arange(0, DIFF_HEAD, 2, dtype=jnp.float32) / DIFF_HEAD)
    ang = pos[:, None] * inv[None, :]
    ang = jnp.concatenate([ang, ang], axis=-1)
    return jnp.cos(ang), jnp.sin(ang)


def apply_rope(t, cos, sin):
    tf = t.astype(jnp.float32)
    t1, t2 = jnp.split(tf, 2, axis=-1)
    rot = jnp.concatenate([-t2, t1], axis=-1)
    c = cos[None, :, None, None, :]
    s = sin[None, :, None, None, :]
    return (tf * c + rot * s).astype(t.dtype)


def rwkv7_scan(r, decay, k, v, kk, a):
    B, L, H, N = r.shape

    def step(S, inp):
        r_t, w_t, k_t, v_t, kk_t, a_t = inp
        sa = jnp.einsum('bhvk,bhk->bhv', S, -kk_t)
        S = (S * w_t[:, :, None, :]
             + sa[..., None] * (kk_t * a_t)[:, :, None, :]
             + v_t[..., None] * k_t[:, :, None, :])
        o = jnp.einsum('bhvk,bhk->bhv', S, r_t)
        return S, o

    xs = tuple(jnp.moveaxis(t, 1, 0) for t in (r, decay, k, v, kk, a))
    S0 = jnp.zeros((B, H, N, N), jnp.float32)
    _, o = lax.scan(step, S0, xs)
    return jnp.moveaxis(o, 0, 1)


def rwkv_pool_mixer(h, w_in, mu, w0, w_up, a0, a_up, g_up, k_k, k_a, r_k,
                    ln_w, ln_b, pool_w, pool_scale, w_out):
    B, L, _ = h.shape
    f32 = jnp.float32
    y = h @ w_in
    ys = y[..., :SHIFT_WIDTH]
    prev = jnp.pad(ys, ((0, 0), (1, 0), (0, 0)))[:, :L]
    ys = ys + (prev - ys) * mu
    r, k, v, wd, ad, gd = jnp.split(ys, RWKV_SPLITS, axis=-1)
    wlog = -jax.nn.softplus(-(w0 + jnp.tanh(wd) @ w_up).astype(f32)) - 0.5
    decay = jnp.exp(-jnp.exp(wlog))
    a = jax.nn.sigmoid((a0 + ad @ a_up).astype(f32))
    g = (jax.nn.sigmoid(gd) @ g_up).astype(f32)
    hs = lambda t: t.reshape(B, L, RWKV_HEADS, RWKV_HEAD)
    kf = k.astype(f32)
    kk = hs(kf * k_k)
    kk = kk / jnp.maximum(jnp.linalg.norm(kk, axis=-1, keepdims=True), 1e-12)
    kf = kf * (1.0 + (a - 1.0) * k_a)
    rf, kf, vf, a_h, dec = hs(r.astype(f32)), hs(kf), hs(v.astype(f32)), hs(a), hs(decay)
    o = rwkv7_scan(rf, dec, kf, vf, kk, a_h)
    mean = jnp.mean(o, axis=-1, keepdims=True)
    var = jnp.mean(jnp.square(o - mean), axis=-1, keepdims=True)
    o = ((o - mean) * lax.rsqrt(var + GN_EPS)).reshape(B, L, RWKV_WIDTH) * ln_w + ln_b
    bonus = jnp.sum(rf * kf * r_k, axis=-1, keepdims=True) * vf
    o = ((o + bonus.reshape(B, L, RWKV_WIDTH)) * g).astype(h.dtype)
    u = y[..., SHIFT_WIDTH:].reshape(B, L, POOL_GROUPS, POOL_GROUP_W).astype(f32)
    t_idx = jnp.arange(L)
    diffs = []
    for gi, win in enumerate(POOL_WINDOWS):
        ug = u[:, :, gi]
        c = jnp.cumsum(ug, axis=1)
        lag = jnp.pad(c, ((0, 0), (win, 0), (0, 0)))[:, :L]
        cnt = jnp.minimum(t_idx + 1, win).astype(f32)[None, :, None]
        diffs.append((c - lag) / cnt - ug)
    d = jnp.stack(diffs, axis=2)
    z = jnp.einsum('blgc,gcd->blgd', d, pool_w.astype(f32)).reshape(B, L, POOL_WIDTH)
    z = (z * pool_scale).astype(h.dtype)
    return jnp.concatenate([o, z], axis=-1) @ w_out


def causal_diff_attention(q, k, v, lam):
    B, L, H, _, dh = q.shape
    nb = -(-L // Q_BLOCK)
    Lp = nb * Q_BLOCK
    pad = Lp - L
    q = jnp.pad(q, ((0, 0), (0, pad), (0, 0), (0, 0), (0, 0)))
    k = jnp.pad(k, ((0, 0), (0, pad), (0, 0), (0, 0), (0, 0)))
    v = jnp.pad(v, ((0, 0), (0, pad), (0, 0), (0, 0)))
    qb = jnp.moveaxis(q.reshape(B, nb, Q_BLOCK, H, 2, dh), 1, 0)
    kpos = jnp.arange(Lp)
    scale = DIFF_HEAD ** -0.5

    def one_block(args):
        qblk, start = args
        s = jnp.einsum('bqhcd,bkhcd->bhcqk', qblk, k).astype(jnp.float32) * scale
        qpos = start + jnp.arange(Q_BLOCK)
        mask = kpos[None, :] <= qpos[:, None]
        s = jnp.where(mask, s, -jnp.inf)
        p = jax.nn.softmax(s, axis=-1)
        attn = p[:, :, 0] - lam * p[:, :, 1]
        return jnp.einsum('bhqk,bkhe->bqhe', attn.astype(v.dtype), v)

    out = lax.map(one_block, (qb, jnp.arange(nb) * Q_BLOCK))
    out = jnp.moveaxis(out, 0, 1).reshape(B, Lp, H, 2 * dh)
    return out[:, :L]


def diff_attn_mixer(h, w_in, lam_vecs, subln_w, w_out, cos, sin, layer):
    B, L, _ = h.shape
    y = h @ w_in
    q, k, v = jnp.split(y, 3, axis=-1)
    q = apply_rope(q.reshape(B, L, DIFF_HEADS, 2, DIFF_HEAD), cos, sin)
    k = apply_rope(k.reshape(B, L, DIFF_HEADS, 2, DIFF_HEAD), cos, sin)
    v = v.reshape(B, L, DIFF_HEADS, 2 * DIFF_HEAD)
    lam_init = 0.8 - 0.6 * math.exp(-0.3 * layer)
    lv = lam_vecs.astype(jnp.float32)
    lam = jnp.exp(jnp.sum(lv[0] * lv[1])) - jnp.exp(jnp.sum(lv[2] * lv[3])) + lam_init
    o = causal_diff_attention(q, k, v, lam)
    o = rmsnorm(o, subln_w, SUBLN_EPS) * (1.0 - lam_init)
    return o.reshape(B, L, D_MODEL).astype(h.dtype) @ w_out


def sq_relu_mlp(h, w1, w2):
    return jnp.square(jax.nn.relu(h @ w1)) @ w2


def setup_inputs(seed: int = 0) -> dict:
    key = jax.random.key(seed)
    ks = jax.random.split(key, 24)
    nrm = lambda i, shape, s: jax.random.normal(ks[i], shape, jnp.float32) * s
    RW = RWKV_WIDTH
    return {
        'x': nrm(0, (BATCH, SEQ, D_MODEL), 1.0),
        'meta': nrm(1, (N_META, D_MODEL), 1.0),
        'norm_g': 1.0 + nrm(2, (DEPTH, 4, D_MODEL), 0.1),
        'mlp_w1': nrm(3, (DEPTH, D_MODEL, D_FF), D_MODEL ** -0.5),
        'mlp_w2': nrm(4, (DEPTH, D_FF, D_MODEL), D_FF ** -0.5),
        'ev_w_in': nrm(5, (N_EVEN, D_MODEL, EVEN_IN), D_MODEL ** -0.5),
        'ev_mu': jax.random.uniform(ks[6], (N_EVEN, SHIFT_WIDTH), jnp.float32),
        'ev_w0': jax.random.uniform(ks[7], (N_EVEN, RW), jnp.float32, -4.0, 1.0),
        'ev_w_up': nrm(8, (N_EVEN, DECAY_RANK, RW), 0.5 * DECAY_RANK ** -0.5),
        'ev_a0': nrm(9, (N_EVEN, RW), 0.1),
        'ev_a_up': nrm(10, (N_EVEN, ICLR_RANK, RW), ICLR_RANK ** -0.5),
        'ev_g_up': nrm(11, (N_EVEN, GATE_RANK, RW), GATE_RANK ** -0.5),
        'ev_k_k': 0.85 + nrm(12, (N_EVEN, RW), 0.05),
        'ev_k_a': 1.0 + nrm(13, (N_EVEN, RW), 0.05),
        'ev_r_k': nrm(14, (N_EVEN, RWKV_HEADS, RWKV_HEAD), 0.1),
        'ev_ln_w': 1.0 + nrm(15, (N_EVEN, RW), 0.1),
        'ev_ln_b': nrm(16, (N_EVEN, RW), 0.02),
        'ev_pool_w': nrm(17, (N_EVEN, POOL_GROUPS, POOL_GROUP_W, POOL_GROUP_W), POOL_GROUP_W ** -0.5),
        'ev_pool_scale': 1.0 + nrm(18, (N_EVEN, POOL_WIDTH), 0.1),
        'ev_w_out': nrm(19, (N_EVEN, D_MODEL, D_MODEL), D_MODEL ** -0.5),
        'od_w_in': nrm(20, (N_ODD, D_MODEL, DIFF_IN), D_MODEL ** -0.5),
        'od_lambda': nrm(21, (N_ODD, 4, DIFF_HEAD), 0.1),
        'od_subln_w': 1.0 + nrm(22, (N_ODD, 2 * DIFF_HEAD), 0.1),
        'od_w_out': nrm(23, (N_ODD, D_MODEL, D_MODEL), D_MODEL ** -0.5),
    }


def reference(x, meta, norm_g, mlp_w1, mlp_w2, ev_w_in, ev_mu, ev_w0, ev_w_up, ev_a0,
              ev_a_up, ev_g_up, ev_k_k, ev_k_a, ev_r_k, ev_ln_w, ev_ln_b, ev_pool_w,
              ev_pool_scale, ev_w_out, od_w_in, od_lambda, od_subln_w, od_w_out):
    B = x.shape[0]
    h = jnp.concatenate([jnp.broadcast_to(meta[None].astype(x.dtype), (B, N_META, D_MODEL)), x], axis=1)
    L = h.shape[1]
    cos, sin = rope_tables(L)
    for i in range(DEPTH):
        g = norm_g[i]
        j = i // 2
        hn = rmsnorm(h, g[0])
        if i % 2 == 0:
            m = rwkv_pool_mixer(hn, ev_w_in[j], ev_mu[j], ev_w0[j], ev_w_up[j], ev_a0[j],
                                ev_a_up[j], ev_g_up[j], ev_k_k[j], ev_k_a[j], ev_r_k[j],
                                ev_ln_w[j], ev_ln_b[j], ev_pool_w[j], ev_pool_scale[j], ev_w_out[j])
        else:
            m = diff_attn_mixer(hn, od_w_in[j], od_lambda[j], od_subln_w[j], od_w_out[j], cos, sin, i)
        h = h + rmsnorm(m, g[1])
        f = sq_relu_mlp(rmsnorm(h, g[2]), mlp_w1[i], mlp_w2[i])
        h = h + rmsnorm(f, g[3])
    return h[:, N_META:]
```

```cpp
#include <hip/hip_runtime.h>
#include <hip/hip_cooperative_groups.h>
#include <cstdio>
#include <cstdint>
namespace cg = cooperative_groups;
#define MK_SINGLE 1
namespace pg8 {
#define PG8_LAS __attribute__((address_space(3)))
typedef unsigned short bf16_t;
typedef short bf16x8 __attribute__((ext_vector_type(8)));
typedef float f32x4 __attribute__((ext_vector_type(4)));
typedef unsigned u32x4 __attribute__((ext_vector_type(4)));
constexpr int BM = 256, BK = 64, HALF = 128, HTB = HALF * BK * 2  , STAGE_BYTES = 8 * HTB, NXCD = 8, WGM = 8;

__host__ __device__ __forceinline__ int lds_byte(int r, int c) { const int st = (r >> 4) * 2 + (c >> 5), rr = r & 15, cc = c & 31, ob = rr * 64 + cc * 2; return st * 1024 + (ob ^ (((ob >> 9) & 1) << 5)); }
__host__ __device__ __forceinline__ void stage_rc(int b, int& R, int& C) { const int st = b / 1024, sb = b % 1024, swz = sb ^ (((sb >> 9) & 1) << 5); R = (st >> 1) * 16 + swz / 64; C = (st & 1) * 32 + (swz % 64) / 2; }
__host__ __device__ __forceinline__ int perm32(int rho) { const int n = rho >> 4, i = rho & 15; return 8 * (i >> 2) + 4 * n + (i & 3); }

struct Unit { int pm, pn; };
struct Gemm { const bf16_t* A; const bf16_t* Bt; int M, N, K; };

struct StaticOrder {
    int nM, nN, nwg, G, c;
    __host__ __device__ void init(int M, int N, int G_, int c_) { nM = M / BM; nN = N / BM; nwg = nM * nN; G = G_; c = c_; }
    __host__ __device__ bool next(int i, Unit& u) const {
        const long L = (long)i * G + c; if (L >= nwg) return false;
        int wgid = (int)L; { const int q = nwg / NXCD, r = nwg % NXCD, xcd = wgid % NXCD, off = wgid / NXCD; wgid = (xcd < r ? xcd * (q + 1) : r * (q + 1) + (xcd - r) * q) + off; }
        const int nig = WGM * nN, gid = wgid / nig, fm = gid * WGM, gsz = (nM - fm) < WGM ? (nM - fm) : WGM;
        u.pm = fm + ((wgid % nig) % gsz); u.pn = (wgid % nig) / gsz; return true;
    }
    __device__ __forceinline__ void a_ready(const Unit&) const {}
    __device__ __forceinline__ void done(const Unit&) const {}
};

__device__ __forceinline__ unsigned cvt_pk_bf16(float lo, float hi) { unsigned r; asm volatile("v_cvt_pk_bf16_f32 %0, %1, %2" : "=v"(r) : "v"(lo), "v"(hi)); return r; }
typedef float f32x2 __attribute__((ext_vector_type(2)));
struct EpiBf16 {
    static constexpr bool PERM = true, AFTER_DRAIN = false;
    bf16_t* O; int ldc; const float* cscale; int split_cols; size_t split_stride; int act;
    __device__ __forceinline__ void operator()(const f32x4 (&acc)[2][2][4][2], const Unit& u, int wr, int wc, int fr, int fq) const {
        const int row0 = u.pm * BM + wr * 64 + fr; int colt = u.pn * BM; bf16_t* base = O;
        if (split_cols) { const int t = colt / split_cols; base += (size_t)t * split_stride; colt -= t * split_cols; }
        const int col0 = colt + wc * 32 + 8 * fq, ccol0 = u.pn * BM + wc * 32 + 8 * fq;
        f32x4 sv[2][2];
#pragma unroll
        for (int bj = 0; bj < 2; ++bj)
#pragma unroll
            for (int n = 0; n < 2; ++n) sv[bj][n] = cscale ? *(const f32x4*)(cscale + ccol0 + bj * HALF + 4 * n) : (f32x4){1.f, 1.f, 1.f, 1.f};
#pragma unroll
        for (int ai = 0; ai < 2; ++ai)
#pragma unroll
            for (int m = 0; m < 4; ++m) { bf16_t* rowp = base + (size_t)(row0 + ai * HALF + m * 16) * ldc + col0;
#pragma unroll
                for (int bj = 0; bj < 2; ++bj) { f32x4 v0 = acc[ai][bj][m][0], v1 = acc[ai][bj][m][1];
                    if (act == 1) {
#pragma unroll
                        for (int e = 0; e < 4; ++e) { const float a = fmaxf(v0[e], 0.f), b = fmaxf(v1[e], 0.f); v0[e] = a * a; v1[e] = b * b; } }
                    v0 = v0 * sv[bj][0]; v1 = v1 * sv[bj][1]; u32x4 w; w.x = cvt_pk_bf16(v0[0], v0[1]); w.y = cvt_pk_bf16(v0[2], v0[3]); w.z = cvt_pk_bf16(v1[0], v1[1]); w.w = cvt_pk_bf16(v1[2], v1[3]);
                    *(u32x4*)(rowp + bj * HALF) = w; } }
    }
};
template <class Epi, class Sched, bool ALIGN_EPI = false, bool SP2 = false>
__device__ __forceinline__ void gemm_phase(PG8_LAS unsigned char* lds, const Gemm g, const Sched& S, const Epi& E, const int tid) {
    const int wid = __builtin_amdgcn_readfirstlane(tid >> 6), lane = tid & 63, wr = wid >> 2, wc = wid & 3, fr = lane & 15, fq = lane >> 4;
    const int K = g.K, nt = K / BK;
    unsigned voffA[2], voffB[2];
#pragma unroll
    for (int i = 0; i < 2; ++i) { int R, C; stage_rc(tid * 16 + i * 8192, R, C); const int Rb = Epi::PERM ? ((R & ~31) + perm32(R & 31)) : R;
        voffA[i] = (unsigned)(R * K + C) * 2u; voffB[i] = (unsigned)(Rb * K + C) * 2u; }
    const size_t kstep = (size_t)(BK * 2);
    const size_t hstep = (size_t)HALF * K * 2;
    const size_t tstep = 2 * hstep;
    const unsigned ldsw = (unsigned)wid * 1024u;
    const int aoff = lds_byte(wr * 64 + fr, fq * 8), boff = lds_byte(wc * 32 + fr, fq * 8);
#define PG8_SA(b, h) (((b) * 2 + (h)) * HTB)
#define PG8_SB(b, h) ((4 + (b) * 2 + (h)) * HTB)
#define PG8_STAGE(bufoff, gbase, voff) do { _Pragma("unroll") for (int _i = 0; _i < 2; ++_i) \
        __builtin_amdgcn_global_load_lds((const unsigned*)((const char*)(gbase) + (voff)[_i]), (PG8_LAS unsigned*)(lds + (bufoff) + ldsw + _i * 8192), 16, 0, 0); } while (0)
#define PG8_LDA(dst, b, h) do { _Pragma("unroll") for (int m = 0; m < 4; ++m) _Pragma("unroll") for (int k = 0; k < 2; ++k) dst[m][k] = *(const PG8_LAS bf16x8*)(lds + PG8_SA(b, h) + aoff + m * 2048 + k * 1024); } while (0)
#define PG8_LDB(dst, b, h) do { _Pragma("unroll") for (int n = 0; n < 2; ++n) _Pragma("unroll") for (int k = 0; k < 2; ++k) dst[n][k] = *(const PG8_LAS bf16x8*)(lds + PG8_SB(b, h) + boff + n * 2048 + k * 1024); } while (0)
#define PG8_MMA(ai, bj, At, Bt) do { __builtin_amdgcn_s_setprio(1); _Pragma("unroll") for (int m = 0; m < 4; ++m) _Pragma("unroll") for (int n = 0; n < 2; ++n) _Pragma("unroll") for (int k = 0; k < 2; ++k) \
        acc[ai][bj][m][n] = __builtin_amdgcn_mfma_f32_16x16x32_bf16(Bt[n][k], At[m][k], acc[ai][bj][m][n], 0, 0, 0); __builtin_amdgcn_s_setprio(0); } while (0)
#define PG8_WAIT_V(n) asm volatile("s_waitcnt vmcnt(" #n ")" ::: "memory")
#define PG8_WAIT_L(n) asm volatile("s_waitcnt lgkmcnt(" #n ")" ::: "memory")
#define PG8_BAR __builtin_amdgcn_s_barrier()
#define PG8_SCHED __builtin_amdgcn_sched_barrier(0)
    Unit cur, nxt; int ui = 0;
    if (!S.next(0, cur)) return;
    f32x4 acc[2][2][4][2];
#pragma unroll
    for (int a = 0; a < 2; ++a)
#pragma unroll
        for (int b = 0; b < 2; ++b)
#pragma unroll
            for (int m = 0; m < 4; ++m)
#pragma unroll
                for (int n = 0; n < 2; ++n) acc[a][b][m][n] = (f32x4){0.f, 0.f, 0.f, 0.f};
    bf16x8 At[4][2], B0[2][2], B1[2][2];
    const char* cA = (const char*)g.A + (size_t)cur.pm * tstep; const char* cB = (const char*)g.Bt + (size_t)cur.pn * tstep;
    S.a_ready(cur);
    if constexpr (SP2) {
        PG8_STAGE(PG8_SB(0, 0), cB, voffB); PG8_STAGE(PG8_SB(0, 1), cB + hstep, voffB); PG8_STAGE(PG8_SA(0, 0), cA, voffA); PG8_STAGE(PG8_SA(0, 1), cA + hstep, voffA);
        if (wr == 1) PG8_BAR;
        PG8_WAIT_V(2); PG8_BAR;
        PG8_STAGE(PG8_SB(1, 0), cB + kstep, voffB); PG8_STAGE(PG8_SA(1, 0), cA + kstep, voffA); PG8_STAGE(PG8_SB(1, 1), cB + hstep + kstep, voffB);
        PG8_WAIT_V(6); PG8_BAR;
    } else {
        PG8_STAGE(PG8_SB(0, 0), cB, voffB); PG8_STAGE(PG8_SA(0, 0), cA, voffA); PG8_STAGE(PG8_SB(0, 1), cB + hstep, voffB); PG8_STAGE(PG8_SA(0, 1), cA + hstep, voffA);
        if (wr == 1) PG8_BAR;
        PG8_WAIT_V(4); PG8_BAR;
        PG8_STAGE(PG8_SB(1, 0), cB + kstep, voffB); PG8_STAGE(PG8_SA(1, 0), cA + kstep, voffA); PG8_STAGE(PG8_SB(1, 1), cB + hstep + kstep, voffB);
        PG8_WAIT_V(6); PG8_BAR;
    }
    for (;;) {
        const bool has_next = S.next(ui + 1, nxt);
        const char* nA = has_next ? (const char*)g.A + (size_t)nxt.pm * tstep : cA; const char* nB = has_next ? (const char*)g.Bt + (size_t)nxt.pn * tstep : cB;
        for (int t = 0; t < nt; t += 2) {
            const bool last = (t == nt - 2);
            const char* a1 = cA + (size_t)(t + 1) * kstep;
            const char* a2 = last ? nA : cA + (size_t)(t + 2) * kstep; const char* b2 = last ? nB : cB + (size_t)(t + 2) * kstep;
            const char* a3 = a2 + kstep; const char* b3 = b2 + kstep;
            if (last && has_next) S.a_ready(nxt);
            if constexpr (SP2) {
            PG8_LDB(B0, 0, 0); PG8_LDB(B1, 0, 1); PG8_SCHED; PG8_LDA(At, 0, 0); PG8_STAGE(PG8_SA(1, 1), a1 + hstep, voffA);
            PG8_WAIT_V(8); PG8_WAIT_L(0); PG8_BAR; PG8_MMA(0, 0, At, B0); PG8_MMA(0, 1, At, B1); PG8_BAR; PG8_SCHED;
            PG8_LDA(At, 0, 1); PG8_STAGE(PG8_SB(0, 0), b2, voffB); PG8_STAGE(PG8_SB(0, 1), b2 + hstep, voffB); PG8_STAGE(PG8_SA(0, 0), a2, voffA);
            PG8_WAIT_V(8); PG8_WAIT_L(0); PG8_BAR; PG8_MMA(1, 0, At, B0); PG8_MMA(1, 1, At, B1); PG8_BAR; PG8_SCHED;
            PG8_LDB(B0, 1, 0); PG8_LDB(B1, 1, 1); PG8_SCHED; PG8_LDA(At, 1, 0); PG8_STAGE(PG8_SA(0, 1), a2 + hstep, voffA);
            PG8_WAIT_V(8); PG8_WAIT_L(0); PG8_BAR; PG8_MMA(0, 0, At, B0); PG8_MMA(0, 1, At, B1); PG8_BAR; PG8_SCHED;
            PG8_LDA(At, 1, 1); PG8_STAGE(PG8_SB(1, 0), b3, voffB); PG8_STAGE(PG8_SB(1, 1), b3 + hstep, voffB); PG8_STAGE(PG8_SA(1, 0), a3, voffA);
            PG8_WAIT_V(8); PG8_WAIT_L(0); PG8_BAR; PG8_MMA(1, 0, At, B0); PG8_MMA(1, 1, At, B1); PG8_BAR; PG8_SCHED;
            } else {
            PG8_LDB(B0, 0, 0); PG8_SCHED; PG8_LDA(At, 0, 0); PG8_STAGE(PG8_SA(1, 1), a1 + hstep, voffA);
            PG8_WAIT_L(8); PG8_BAR; PG8_WAIT_L(0); PG8_MMA(0, 0, At, B0); PG8_BAR; PG8_SCHED;
            PG8_LDB(B1, 0, 1); PG8_STAGE(PG8_SB(0, 0), b2, voffB);
            PG8_BAR; PG8_WAIT_L(0); PG8_MMA(0, 1, At, B1); PG8_BAR;
            PG8_LDA(At, 0, 1); PG8_STAGE(PG8_SA(0, 0), a2, voffA);
            PG8_BAR; PG8_WAIT_L(0); PG8_MMA(1, 0, At, B0); PG8_BAR; PG8_SCHED;
            PG8_STAGE(PG8_SB(0, 1), b2 + hstep, voffB);
            PG8_WAIT_V(6); PG8_BAR; PG8_MMA(1, 1, At, B1); PG8_BAR;
            PG8_LDB(B0, 1, 0); PG8_SCHED; PG8_LDA(At, 1, 0); PG8_STAGE(PG8_SA(0, 1), a2 + hstep, voffA);
            PG8_WAIT_L(8); PG8_BAR; PG8_WAIT_L(0); PG8_MMA(0, 0, At, B0); PG8_BAR; PG8_SCHED;
            PG8_LDB(B1, 1, 1); PG8_STAGE(PG8_SB(1, 0), b3, voffB);
            PG8_BAR; PG8_WAIT_L(0); PG8_MMA(0, 1, At, B1); PG8_BAR;
            PG8_LDA(At, 1, 1); PG8_STAGE(PG8_SA(1, 0), a3, voffA);
            PG8_BAR; PG8_WAIT_L(0); PG8_MMA(1, 0, At, B0); PG8_BAR; PG8_SCHED;
            PG8_STAGE(PG8_SB(1, 1), b3 + hstep, voffB);
            PG8_WAIT_V(6); PG8_BAR; PG8_MMA(1, 1, At, B1); PG8_BAR;
            }
        }
        if constexpr (ALIGN_EPI) { if (wr == 0) PG8_BAR; }
        if constexpr (!Epi::AFTER_DRAIN) { E(acc, cur, wr, wc, fr, fq); S.done(cur); }
        if (!has_next) break;
#pragma unroll
        for (int a = 0; a < 2; ++a)
#pragma unroll
            for (int b = 0; b < 2; ++b)
#pragma unroll
                for (int m = 0; m < 4; ++m)
#pragma unroll
                    for (int n = 0; n < 2; ++n) acc[a][b][m][n] = (f32x4){0.f, 0.f, 0.f, 0.f};
        cur = nxt; cA = nA; cB = nB; ++ui;
        if constexpr (ALIGN_EPI) { if (wr == 1) PG8_BAR; }
    }
    PG8_WAIT_V(0);
    if constexpr (!ALIGN_EPI) { if (wr == 0) PG8_BAR; }
    PG8_BAR;
    if constexpr (Epi::AFTER_DRAIN) { E.fused(acc, cur, wr, wc, fr, fq, lds, wid, lane); S.done(cur); }
#undef PG8_SA
#undef PG8_SB
#undef PG8_STAGE
#undef PG8_LDA
#undef PG8_LDB
#undef PG8_MMA
#undef PG8_WAIT_V
#undef PG8_WAIT_L
#undef PG8_BAR
#undef PG8_SCHED
}
}
#include <hip/hip_bf16.h>
#include <cmath>
namespace attn_body {
using bf16=__hip_bfloat16;
using bf16x8=__attribute__((ext_vector_type(8)))short;
using s16x4=__attribute__((ext_vector_type(4)))short;
using f32x16=__attribute__((ext_vector_type(16)))float;
using u32x4=__attribute__((ext_vector_type(4)))unsigned;
constexpr int D=64,DM=1024;
constexpr int NW=8,QBLK=32,QB=QBLK*NW,KVBLK=64;
constexpr int ATTN_PITCH=DM, ATTN_UNIT_ROWS=QB;
__device__ __forceinline__ int crow(int r,int hi){return (r&3)+8*(r>>2)+4*hi;}
#define SBAR() __builtin_amdgcn_sched_barrier(0)
__device__ __forceinline__ void cmask(f32x16&p0,f32x16&p1,int jb,int qrel,int hi){
  const float NEG=-INFINITY; int kb=64*jb+4*hi;
  #pragma unroll
  for(int r=0;r<16;++r){int kv=kb+(r&3)+8*(r>>2); if(kv>qrel)p0[r]=NEG; if(kv+32>qrel)p1[r]=NEG;}
}

constexpr int NSLOT=3, SLOTB=8192;
constexpr int LDS_K=0, LDS_V=NSLOT*SLOTB, LDS_WS=2*NSLOT*SLOTB, LDS_OST=LDS_WS+NW*64*4, LDS_BYTES=LDS_OST+NW*4096;
constexpr float C2=0.125f*1.4426950408889634f;
__device__ __forceinline__ void glds16(const void*gsrc,unsigned lds_dst){unsigned keep;
  asm volatile("s_mov_b32 %0, m0\n\ts_mov_b32 m0, %2\n\ts_nop 0\n\tglobal_load_lds_dwordx4 %1, off\n\ts_mov_b32 m0, %0":"=&s"(keep):"v"(gsrc),"s"(lds_dst):"memory");}
__device__ __forceinline__ float max3f(float a,float b,float c){float r;asm("v_max3_f32 %0, %1, %2, %3":"=v"(r):"v"(a),"v"(b),"v"(c));return r;}
__device__ __forceinline__ float max2f(float a,float b){float r;asm("v_max_f32_e32 %0, %1, %2":"=v"(r):"v"(a),"v"(b));return r;}
__device__ __forceinline__ float fadd_s(float a,float b){float r;asm("v_add_f32_e32 %0, %1, %2":"=v"(r):"v"(a),"v"(b));return r;}
__device__ __forceinline__ float fsub_s(float a,float b){float r;asm("v_sub_f32_e32 %0, %1, %2":"=v"(r):"v"(a),"v"(b));return r;}
typedef float f32x2_t __attribute__((ext_vector_type(2))); typedef __bf16 bf16x2_t __attribute__((ext_vector_type(2)));
__device__ __forceinline__ unsigned cvtpk_s(float lo,float hi){f32x2_t v={lo,hi};bf16x2_t b=__builtin_convertvector(v,bf16x2_t);return __builtin_bit_cast(unsigned,b);}
#define WAIT_BAR(N) asm volatile("s_waitcnt vmcnt(" #N ") lgkmcnt(0)\n\ts_barrier":::"memory")

__device__ __forceinline__ void qkt(f32x16&p0,f32x16&p1,const char*Kslot,const bf16x8*qr,const f32x16&negm,int r32,int hi){
  const char*kb=Kslot+hi*1024+r32*16;
  #pragma unroll
  for(int d0=0;d0<4;++d0){
    const bf16x8 b0=*reinterpret_cast<const bf16x8*>(kb+d0*2048);
    const bf16x8 b1=*reinterpret_cast<const bf16x8*>(kb+d0*2048+512);
    if(d0==0){p0=__builtin_amdgcn_mfma_f32_32x32x16_bf16(b0,qr[0],negm,0,0,0);p1=__builtin_amdgcn_mfma_f32_32x32x16_bf16(b1,qr[0],negm,0,0,0);}
    else{p0=__builtin_amdgcn_mfma_f32_32x32x16_bf16(b0,qr[d0],p0,0,0,0);p1=__builtin_amdgcn_mfma_f32_32x32x16_bf16(b1,qr[d0],p1,0,0,0);}}
}
typedef __attribute__((address_space(3))) const char* lds_cptr;
typedef short v4i16_t __attribute__((ext_vector_type(4)));
__device__ __forceinline__ void kload8(bf16x8*kf,lds_cptr kp){
  kf[0]=*(const __attribute__((address_space(3))) bf16x8*)(kp);      kf[1]=*(const __attribute__((address_space(3))) bf16x8*)(kp+512);
  kf[2]=*(const __attribute__((address_space(3))) bf16x8*)(kp+2048); kf[3]=*(const __attribute__((address_space(3))) bf16x8*)(kp+2560);
  kf[4]=*(const __attribute__((address_space(3))) bf16x8*)(kp+4096); kf[5]=*(const __attribute__((address_space(3))) bf16x8*)(kp+4608);
  kf[6]=*(const __attribute__((address_space(3))) bf16x8*)(kp+6144); kf[7]=*(const __attribute__((address_space(3))) bf16x8*)(kp+6656);
}
__device__ __forceinline__ void kload2(bf16x8*kf,lds_cptr kp,int j){ kf[2*j]=*(const __attribute__((address_space(3))) bf16x8*)(kp+j*2048); kf[2*j+1]=*(const __attribute__((address_space(3))) bf16x8*)(kp+j*2048+512); }
__device__ __forceinline__ s16x4 vtr(lds_cptr p){ return __builtin_bit_cast(s16x4,__builtin_amdgcn_ds_read_tr16_b64_v4i16((__attribute__((address_space(3))) v4i16_t*)p)); }
__device__ __forceinline__ float rowmax(const f32x16&p0,const f32x16&p1){
  float a=max3f(p0[0],p0[1],p1[0]),b=max3f(p0[2],p0[3],p1[1]);a=max3f(a,p1[2],p1[3]);
  #pragma unroll
  for(int r=4;r<16;r+=4){a=max3f(a,p0[r],p0[r+1]);b=max3f(b,p0[r+2],p0[r+3]);a=max3f(a,p1[r],p1[r+1]);b=max3f(b,p1[r+2],p1[r+3]);}
  const float m=max2f(a,b);
  auto rr=__builtin_amdgcn_permlane32_swap(__float_as_uint(m),__float_as_uint(m),false,false);
  return max2f(__uint_as_float(rr[0]),__uint_as_float(rr[1]));
}
__device__ __forceinline__ void pv(f32x16*o,int vb,bf16x8 pa0,bf16x8 pa1,bf16x8 pa2,bf16x8 pa3){
  #pragma unroll
  for(int d0=0;d0<2;++d0){s16x4 lo[4],hi[4];
    #pragma unroll
    for(int ks=0;ks<4;++ks){
      asm volatile("ds_read_b64_tr_b16 %0,%1 offset:%c2":"=&v"(lo[ks]):"v"(vb),"i"(d0*4096+ks*1024):"memory");
      asm volatile("ds_read_b64_tr_b16 %0,%1 offset:%c2":"=&v"(hi[ks]):"v"(vb),"i"(d0*4096+ks*1024+512):"memory");}
    asm volatile("s_waitcnt lgkmcnt(0)":::"memory");SBAR();
    #define PK(k) (bf16x8){lo[k][0],lo[k][1],lo[k][2],lo[k][3],hi[k][0],hi[k][1],hi[k][2],hi[k][3]}
    o[d0]=__builtin_amdgcn_mfma_f32_32x32x16_bf16(pa0,PK(0),o[d0],0,0,0);
    o[d0]=__builtin_amdgcn_mfma_f32_32x32x16_bf16(pa1,PK(1),o[d0],0,0,0);
    o[d0]=__builtin_amdgcn_mfma_f32_32x32x16_bf16(pa2,PK(2),o[d0],0,0,0);
    o[d0]=__builtin_amdgcn_mfma_f32_32x32x16_bf16(pa3,PK(3),o[d0],0,0,0);
    #undef PK
  }
}

#ifndef ATTN_STORE16
#define ATTN_STORE16(p,v) (*(u32x4*)(p)=(v))
#endif
template<int THRL> __device__ __forceinline__ void attn_unit(int qb,const bf16*Qh,const bf16*__restrict__ Kh,const bf16*__restrict__ Vh,bf16*Oh,char*shm,const int tid){
  const int lane=tid&63,r32=lane&31,hi=lane>>5; const int wid=__builtin_amdgcn_readfirstlane(tid>>6);
  const int q0=qb*QB;
  const bf16*Qw=Qh+(long)(q0+wid*QBLK)*DM;
  const unsigned lds0=(unsigned)(uintptr_t)shm;
  float*wsf=(float*)(shm+LDS_WS)+wid*64;
  const bf16*ksrc=Kh+(long)lane*DM+wid*8;
  const bf16*vsrc=Vh+(long)(16*(wid&3)+(lane>>2))*DM+(wid>>2)*32+(lane&3)*8;
  const unsigned kdst=lds0+LDS_K+wid*1024, vdst=lds0+LDS_V+wid*1024;
  #define DMA_K(t,slot) glds16(ksrc+(long)(t)*KVBLK*DM,(unsigned)__builtin_amdgcn_readfirstlane(kdst+(slot)))
  #define DMA_V(t,slot) glds16(vsrc+(long)(t)*KVBLK*DM,(unsigned)__builtin_amdgcn_readfirstlane(vdst+(slot)))
  const int vb0=(int)(lds0+LDS_V)+((lane>>4)&1)*32+(lane&3)*8+(4*hi+((lane&15)>>2))*64;
  const char*Kbase=shm+LDS_K; bf16x8 kf[8];
  const lds_cptr shm3=(lds_cptr)shm; const lds_cptr kp0=shm3+LDS_K+hi*1024+r32*16; const lds_cptr vp0=shm3+LDS_V+((lane>>4)&1)*32+(lane&3)*8+(4*hi+((lane&15)>>2))*64;
  const int NT=(q0+QB)/KVBLK;
  DMA_K(0,0);DMA_V(0,0);DMA_K(1,SLOTB);
  bf16x8 qr[4];
  #pragma unroll
  for(int d0=0;d0<4;++d0)qr[d0]=*reinterpret_cast<const bf16x8*>(&Qw[(long)r32*DM+d0*16+hi*8]);
  float mhat=0.f,l_reg=0.f;f32x16 o[2];o[0]=f32x16{};o[1]=f32x16{};float zf_=0.f;asm volatile("":"+v"(zf_));f32x16 negm;
  _Pragma("unroll") for(int r=0;r<16;++r)negm[r]=zf_;
  asm volatile("":"+v"(negm));
  const int qrel=wid*QBLK+r32;
  #define CMASK(P0,P1,t) do{int jb_=(t)-(NT-4); if(jb_>=0)cmask(P0,P1,jb_,qrel,hi);}while(0)
  bool resc=false;
  #define START(P0,P1) do{ const float rm=rowmax(P0,P1); resc=false; \
    { const float dl=rm; mhat=fadd_s(mhat,dl); \
      _Pragma("unroll") for(int r=0;r<16;++r){P0[r]=fsub_s(P0[r],dl);P1[r]=fsub_s(P1[r],dl);} \
      _Pragma("unroll") for(int r=0;r<16;++r)negm[r]=-mhat; asm volatile("":"+v"(negm)); } \
    _Pragma("unroll") for(int r=0;r<16;++r)P0[r]=__builtin_amdgcn_exp2f(P0[r]); }while(0)
  #define RESC() do{ if(resc){ asm volatile("s_waitcnt lgkmcnt(0)":::"memory"); \
      _Pragma("unroll") for(int d_=0;d_<2;++d_) _Pragma("unroll") for(int r=0;r<16;++r)o[d_][r]*=wsf[crow(r,hi)]; } }while(0)
  f32x16 pA0,pA1,pB0,pB1;
  int sl_prev=0,sl_cur=0,sl_next=SLOTB;
  #define ROT() do{sl_prev=sl_cur;sl_cur=sl_next;sl_next=(sl_next==(NSLOT-1)*SLOTB)?0:sl_next+SLOTB;}while(0)
  DMA_K(2,2*SLOTB);
  WAIT_BAR(3);
  qkt(pA0,pA1,Kbase,qr,negm,r32,hi);asm volatile("s_nop 15\n\ts_nop 7":"+v"(pA0),"+v"(pA1));CMASK(pA0,pA1,0);
  START(pA0,pA1);
  _Pragma("unroll") for(int r=0;r<16;++r)pA1[r]=__builtin_amdgcn_exp2f(pA1[r]);
  WAIT_BAR(0);
  DMA_K(3,0);DMA_V(1,SLOTB);
  ROT();
  kload8(kf,kp0+sl_cur);
  WAIT_BAR(2);
  s16x4 vlo[8],vhi[8]; u32x4 pw0,pw1,pw2,pw3;
  #define PKW(P,B) cvtpk_s(P[B],P[B+1])
  #define PAF(k) __builtin_bit_cast(bf16x8,pw##k)
  #define VFR(i) (bf16x8){vlo[i][0],vlo[i][1],vlo[i][2],vlo[i][3],vhi[i][0],vhi[i][1],vhi[i][2],vhi[i][3]}
  #define PIN(x) asm volatile("":"+v"(x))
  #define MX3(a,b,c) __builtin_fmaxf(__builtin_fmaxf((a),(b)),(c))
  #define GAPA(MF,A0,A1,A2,A3,W0,W1,PW) do{ MF; sacc+=A0; sacc+=A1; sacc+=A2; sacc+=A3; PIN(sacc); W0; W1; PIN(PW); SBAR(); }while(0)
  #define EX(v) __builtin_amdgcn_exp2f(v)
  #define GAPB(MF,X,B) do{ MF; X[B]=EX(X[B]); X[B+1]=EX(X[B+1]); X[B+2]=EX(X[B+2]); X[B+3]=EX(X[B+3]); PIN(X); SBAR(); }while(0)
  #define VRD(i) do{ vlo[i]=vtr(vp_+(((i)>>2)*4096+((i)&3)*1024)); vhi[i]=vtr(vp_+(((i)>>2)*4096+((i)&3)*1024+512)); }while(0)
  #define KRD(G,j) do{ if(G){ kload2(kf,kp0+sl_next,j); SBAR(); } }while(0)
  #define STEP(C0,C1,P0,P1,t,GK,GV,GL) do{ SBAR(); \
    const lds_cptr vp_=vp0+sl_prev; \
    VRD(0); SBAR(); float sacc=(P0[0]+P0[1]); \
    GAPA(C0=__builtin_amdgcn_mfma_f32_32x32x16_bf16(kf[0],qr[0],negm,0,0,0), P0[2],P0[3],P0[4],P0[5],     pw0[0]=PKW(P0,0), pw0[1]=PKW(P0,2), pw0); \
    VRD(4); SBAR(); GAPA(C1=__builtin_amdgcn_mfma_f32_32x32x16_bf16(kf[1],qr[0],negm,0,0,0), P0[6],P0[7],P0[8],P0[9],     pw0[2]=PKW(P0,4), pw0[3]=PKW(P0,6), pw0); \
    VRD(1); SBAR(); GAPA(C0=__builtin_amdgcn_mfma_f32_32x32x16_bf16(kf[2],qr[1],C0,0,0,0),   P0[10],P0[11],P0[12],P0[13], pw1[0]=PKW(P0,8), pw1[1]=PKW(P0,10), pw1); \
    VRD(5); SBAR(); GAPA(C1=__builtin_amdgcn_mfma_f32_32x32x16_bf16(kf[3],qr[1],C1,0,0,0),   P0[14],P0[15],P1[0],P1[1],   pw1[2]=PKW(P0,12),pw1[3]=PKW(P0,14), pw1); \
    VRD(2); SBAR(); GAPA(C0=__builtin_amdgcn_mfma_f32_32x32x16_bf16(kf[4],qr[2],C0,0,0,0),   P1[2],P1[3],P1[4],P1[5],     pw2[0]=PKW(P1,0), pw2[1]=PKW(P1,2), pw2); \
    VRD(6); SBAR(); GAPA(C1=__builtin_amdgcn_mfma_f32_32x32x16_bf16(kf[5],qr[2],C1,0,0,0),   P1[6],P1[7],P1[8],P1[9],     pw2[2]=PKW(P1,4), pw2[3]=PKW(P1,6), pw2); \
    VRD(3); SBAR(); GAPA(C0=__builtin_amdgcn_mfma_f32_32x32x16_bf16(kf[6],qr[3],C0,0,0,0),   P1[10],P1[11],P1[12],P1[13], pw3[0]=PKW(P1,8), pw3[1]=PKW(P1,10), pw3); \
    VRD(7); SBAR(); GAPA(C1=__builtin_amdgcn_mfma_f32_32x32x16_bf16(kf[7],qr[3],C1,0,0,0),   P1[14],P1[15],0.f,0.f,       pw3[2]=PKW(P1,12),pw3[3]=PKW(P1,14), pw3); \
    l_reg+=sacc; \
    if(GK){DMA_K((t)+3,sl_cur);} if(GV){DMA_V((t)+1,sl_next);} \
    CMASK(C0,C1,t); \
    { float a=MX3(C0[0],C0[1],C1[0]),b=MX3(C0[2],C0[3],C1[1]); a=MX3(a,C1[2],C1[3]); \
      _Pragma("unroll") for(int r=4;r<16;r+=4){a=MX3(a,C0[r],C0[r+1]);b=MX3(b,C0[r+2],C0[r+3]);a=MX3(a,C1[r],C1[r+1]);b=MX3(b,C1[r+2],C1[r+3]);} \
      float rm=__builtin_fmaxf(a,b); { auto rr=__builtin_amdgcn_permlane32_swap(__float_as_uint(rm),__float_as_uint(rm),false,false); rm=__builtin_fmaxf(__uint_as_float(rr[0]),__uint_as_float(rr[1])); } \
      resc=false; \
      if(__builtin_expect(__any(rm>(float)THRL),0)){ const float dl=__builtin_fmaxf(rm,0.f); mhat+=dl; \
        _Pragma("unroll") for(int r=0;r<16;++r){C0[r]-=dl;C1[r]-=dl;} \
        _Pragma("unroll") for(int r=0;r<16;++r)negm[r]=-mhat; asm volatile("":"+v"(negm)); \
        const float f=__builtin_amdgcn_exp2f(-dl); l_reg*=f; if(hi==0)wsf[r32]=f; resc=true; } } \
    SBAR(); \
    GAPB(o[0]=__builtin_amdgcn_mfma_f32_32x32x16_bf16(PAF(0),VFR(0),o[0],0,0,0), C0,0); \
    GAPB(o[1]=__builtin_amdgcn_mfma_f32_32x32x16_bf16(PAF(0),VFR(4),o[1],0,0,0), C0,4); \
    KRD(GL,0); GAPB(o[0]=__builtin_amdgcn_mfma_f32_32x32x16_bf16(PAF(1),VFR(1),o[0],0,0,0), C0,8); \
    KRD(GL,1); GAPB(o[1]=__builtin_amdgcn_mfma_f32_32x32x16_bf16(PAF(1),VFR(5),o[1],0,0,0), C0,12); \
    KRD(GL,2); GAPB(o[0]=__builtin_amdgcn_mfma_f32_32x32x16_bf16(PAF(2),VFR(2),o[0],0,0,0), C1,0); \
    KRD(GL,3); GAPB(o[1]=__builtin_amdgcn_mfma_f32_32x32x16_bf16(PAF(2),VFR(6),o[1],0,0,0), C1,4); \
    GAPB(o[0]=__builtin_amdgcn_mfma_f32_32x32x16_bf16(PAF(3),VFR(3),o[0],0,0,0), C1,8); \
    GAPB(o[1]=__builtin_amdgcn_mfma_f32_32x32x16_bf16(PAF(3),VFR(7),o[1],0,0,0), C1,12); \
    }while(0)
  int t=1;
  #undef CMASK
  #define CMASK(P0,P1,t) do{}while(0)
  for(;t+5<NT;t+=2){
    STEP(pB0,pB1,pA0,pA1,t,true,true,true);     WAIT_BAR(2); RESC(); ROT();
    STEP(pA0,pA1,pB0,pB1,t+1,true,true,true);   WAIT_BAR(2); RESC(); ROT();
  }
  #undef CMASK
  #define CMASK(P0,P1,t) do{int jb_=(t)-(NT-4); if(jb_>=0)cmask(P0,P1,jb_,qrel,hi);}while(0)
  #define ENDW(tt) do{ if((tt)+3<NT){WAIT_BAR(2);} else if((tt)+2<NT){WAIT_BAR(1);} else {WAIT_BAR(0);} }while(0)
  for(;t+1<NT;t+=2){
    STEP(pB0,pB1,pA0,pA1,t,(t+3<NT),(t+1<NT),(t+1<NT));       ENDW(t);   RESC(); ROT();
    STEP(pA0,pA1,pB0,pB1,t+1,(t+4<NT),(t+2<NT),(t+2<NT));     ENDW(t+1); RESC(); ROT();
  }
  STEP(pB0,pB1,pA0,pA1,NT-1,false,false,false); RESC();
  { float sacc=pB0[0]+pB0[1]; _Pragma("unroll") for(int r=2;r<16;++r)sacc+=pB0[r]; _Pragma("unroll") for(int r=0;r<16;++r)sacc+=pB1[r]; l_reg+=sacc;
    pw0=(u32x4){PKW(pB0,0),PKW(pB0,2),PKW(pB0,4),PKW(pB0,6)};pw1=(u32x4){PKW(pB0,8),PKW(pB0,10),PKW(pB0,12),PKW(pB0,14)};pw2=(u32x4){PKW(pB1,0),PKW(pB1,2),PKW(pB1,4),PKW(pB1,6)};pw3=(u32x4){PKW(pB1,8),PKW(pB1,10),PKW(pB1,12),PKW(pB1,14)};
    SBAR(); pv(o,vb0+sl_cur,PAF(0),PAF(1),PAF(2),PAF(3)); }
  #undef PKW
  #undef PAF
  #undef VFR
  #undef PIN
  #undef MX3
  #undef GAPA
  #undef GAPB
  #undef EX
  #undef VRD
  #undef KRD
  #undef STEP
  #undef ENDW
  {auto rr=__builtin_amdgcn_permlane32_swap(__float_as_uint(l_reg),__float_as_uint(l_reg),false,false);l_reg=__uint_as_float(rr[0])+__uint_as_float(rr[1]);}
  if(hi==0)wsf[32+r32]=l_reg;asm volatile("s_waitcnt lgkmcnt(0)":::"memory");
  float rli[16];
  #pragma unroll
  for(int r=0;r<16;++r)rli[r]=__builtin_amdgcn_rcpf(wsf[32+crow(r,hi)]);
  bf16*Ow=Oh+(long)(q0+wid*QBLK)*DM;
  { bf16*stg=(bf16*)(shm+LDS_OST)+wid*2048;
    #pragma unroll
    for(int r=0;r<16;++r){const int orow=crow(r,hi);
      #pragma unroll
      for(int d0=0;d0<2;++d0)stg[orow*64+d0*32+r32]=__float2bfloat16(o[d0][r]*rli[r]);}
    asm volatile("s_waitcnt lgkmcnt(0)":::"memory");
    #pragma unroll
    for(int i=0;i<4;++i){const int row=i*8+(lane>>3),ch=lane&7; const u32x4 v=*(const u32x4*)(stg+row*64+ch*8); ATTN_STORE16(Ow+(long)row*DM+ch*8,v);} }
  asm volatile("s_waitcnt lgkmcnt(0)\n\ts_barrier":::"memory");
  #undef DMA_K
  #undef DMA_V
  #undef CMASK
  #undef START
  #undef RESC
  #undef ROT
}
constexpr int ATTN_LDS_BYTES=LDS_BYTES;
#undef SBAR
#undef WAIT_BAR
}
#define LAS __attribute__((address_space(3)))
#define GAS __attribute__((address_space(1)))
typedef unsigned short bf16;
typedef unsigned v4u __attribute__((ext_vector_type(4)));
typedef unsigned v2u __attribute__((ext_vector_type(2)));
typedef float f32x4 __attribute__((ext_vector_type(4)));
#ifndef MK_SINGLE
#define MK_SINGLE 1
#endif
constexpr int NWAVES = 8;
constexpr int L = 16400, LP = 16640, TP = 16512, NCH = 129, CHT = 128, NMETA = 16, NPH = 43;
constexpr size_t MiB = 1u << 20, HMiB = 1u << 19;
constexpr size_t WS_HM = HMiB, WS_WIN = 1 * MiB, WS_WOUT = 7 * MiB, WS_W1 = 9 * MiB, WS_W2 = 17 * MiB, WS_WLR = 25 * MiB, WS_WPOOL = 26 * MiB;
constexpr size_t WS_XN = 27 * MiB, WS_DP = 27 * MiB, WS_Z = 43 * MiB + HMiB;
constexpr size_t WS_Y = 59 * MiB + HMiB, WS_LR = WS_Y, WS_PP = WS_Y, WS_M1E = WS_Y, WS_F = WS_Y, WS_OZO = WS_Y;
constexpr size_t WS_OZE = 108 * MiB + HMiB, WS_BON = 141 * MiB, WS_REC = 143 * MiB;
constexpr size_t WS_Q = 92 * MiB, WS_K = 124 * MiB + HMiB, WS_V = 157 * MiB, WS_O0 = 189 * MiB + HMiB, WS_O1 = 222 * MiB, WS_M1O = 92 * MiB, WS_HID = 92 * MiB;
constexpr size_t WS_END = 256 * MiB;
constexpr size_t ACT_BYTES = (size_t)LP * 1024 * 2;
static_assert(WS_REC + (size_t)TP * 8 * 448 * 2 <= WS_END && WS_O1 + ACT_BYTES <= WS_END && WS_HID + 4 * ACT_BYTES <= WS_END, "ws map");
static_assert(WS_Y + (size_t)LP * 2304 * 2 <= WS_REC && WS_LR + (size_t)LP * 1536 * 2 <= WS_OZE && WS_OZE + ACT_BYTES <= WS_BON && WS_K - WS_Q == ACT_BYTES && WS_V - WS_K == ACT_BYTES, "ws map 2");
constexpr int LDS_BYTES = 147456;
constexpr float C2Q = 0.125f * 1.4426950408889634f;

__device__ __forceinline__ unsigned f2bf(float f) { unsigned u = __builtin_bit_cast(unsigned, f); return (u + 0x7fffu + ((u >> 16) & 1u)) >> 16; }
__device__ __forceinline__ unsigned pk2(float lo, float hi) { return f2bf(lo) | (f2bf(hi) << 16); }
__device__ __forceinline__ float bf2f(bf16 b) { return __builtin_bit_cast(float, (unsigned)b << 16); }
__device__ __forceinline__ float bflo(unsigned w) { return __builtin_bit_cast(float, w << 16); }
__device__ __forceinline__ float bfhi(unsigned w) { return __builtin_bit_cast(float, w & 0xffff0000u); }
__device__ __forceinline__ float wave_sum(float v) {
#pragma unroll
    for (int o = 1; o < 64; o <<= 1) v += __shfl_xor(v, o);
    return v;
}
struct Args { const float* in[24]; float* out; unsigned char* ws; int ph_lo, ph_hi; };
__device__ __forceinline__ const float* inp_ptr(const Args& a, int i) { asm volatile("" : "+s"(i)); return a.in[i]; }

__device__ __forceinline__ void transpose_item(const float* W, int K, int N, bf16* WT, LAS float* scr, int item, int lane) {
    const int nblk = N / 32, kb = item / nblk, nb = item % nblk, k0 = 64 * kb, n0 = 32 * nb;
#pragma unroll 8
    for (int i = 0; i < 32; ++i) { const int kk = 2 * i + (lane >> 5); scr[kk * 33 + (lane & 31)] = W[(size_t)(k0 + kk) * N + n0 + (lane & 31)]; }
    asm volatile("s_waitcnt lgkmcnt(0)" ::: "memory");
    const int c = lane & 7;
#pragma unroll
    for (int j = 0; j < 4; ++j) { const int n = (lane >> 3) + 8 * j; const LAS float* s = scr + (8 * c) * 33 + n;
        v4u o; o.x = pk2(s[0 * 33], s[1 * 33]); o.y = pk2(s[2 * 33], s[3 * 33]); o.z = pk2(s[4 * 33], s[5 * 33]); o.w = pk2(s[6 * 33], s[7 * 33]);
        *(v4u*)(WT + (size_t)(n0 + n) * K + k0 + 8 * c) = o; }
    asm volatile("s_waitcnt lgkmcnt(0)" ::: "memory");
}
__device__ __forceinline__ void wconv(const Args& a, int layer, LAS float* scr, int gw, int NGW, int lane, int gtid, int NTHR) {
    const int j = layer >> 1; const bool odd = layer & 1; unsigned char* ws = a.ws;
    const float* Win = odd ? inp_ptr(a, 20) + (size_t)j * 1024 * 3072 : inp_ptr(a, 5) + (size_t)j * 1024 * 2304; const int Nin = odd ? 3072 : 2304;
    const float* Wout = (odd ? inp_ptr(a, 23) : inp_ptr(a, 19)) + (size_t)j * 1024 * 1024;
    const float* W1 = inp_ptr(a, 3) + (size_t)layer * 1024 * 4096; const float* W2 = inp_ptr(a, 4) + (size_t)layer * 4096 * 1024;
    const int I_in = 16 * (Nin / 32), I_out = 16 * 32, I_1 = 16 * 128, I_2 = 64 * 32;
    for (int it = gw; it < I_in + I_out + I_1 + I_2; it += NGW) {
        int r = it;
        if (r < I_in) { transpose_item(Win, 1024, Nin, (bf16*)(ws + WS_WIN), scr, r, lane); continue; } r -= I_in;
        if (r < I_out) { transpose_item(Wout, 1024, 1024, (bf16*)(ws + WS_WOUT), scr, r, lane); continue; } r -= I_out;
        if (r < I_1) { transpose_item(W1, 1024, 4096, (bf16*)(ws + WS_W1), scr, r, lane); continue; } r -= I_1;
        transpose_item(W2, 4096, 1024, (bf16*)(ws + WS_W2), scr, r, lane);
    }
    if (!odd) {
        const float* w_up = inp_ptr(a, 8) + (size_t)j * 64 * 512; const float* a_up = inp_ptr(a, 10) + (size_t)j * 64 * 512; const float* g_up = inp_ptr(a, 11) + (size_t)j * 128 * 512;
        const float* pw = inp_ptr(a, 17) + (size_t)j * 4 * 128 * 128;
        bf16* WLR = (bf16*)(ws + WS_WLR); bf16* WPL = (bf16*)(ws + WS_WPOOL);
        for (int idx = gtid; idx < 1536 * 256; idx += NTHR) { const int n = idx >> 8, k = idx & 255; float v = 0.f;
            if (n < 512) { if (k < 64) v = w_up[k * 512 + n]; }
            else if (n < 1024) { if (k >= 64 && k < 128) v = a_up[(k - 64) * 512 + (n - 512)]; }
            else { if (k >= 128) v = g_up[(k - 128) * 512 + (n - 1024)]; }
            WLR[idx] = (bf16)f2bf(v); }
        for (int idx = gtid; idx < 512 * 512; idx += NTHR) { const int n = idx >> 9, k = idx & 511; const int g = n >> 7; float v = 0.f;
            if ((k >> 7) == g) v = pw[((size_t)g * 128 + (k & 127)) * 128 + (n & 127)];
            WPL[idx] = (bf16)f2bf(v); }
    }
}
__device__ __forceinline__ void norm_rows(int mode, const float* xin, const float* meta, float* out, float* hm, const bf16* Msrc, const float* ga, const float* gb, bf16* XN, int gw, int NGW, int lane) {
    for (int t = gw; t < LP; t += NGW) {
        v2u* xo = (v2u*)(XN + (size_t)t * 1024) + lane;
        if (t >= L) { if (mode != 2) {
#pragma unroll
                for (int j = 0; j < 4; ++j) xo[64 * j] = (v2u){0u, 0u}; }
            continue; }
        if (mode == 2 && t < NMETA) continue;
        float* hrow = t < NMETA ? hm + (size_t)t * 1024 : out + (size_t)(t - NMETA) * 1024;
        f32x4 v[4];
        if (mode == 0) { const float* src = t < NMETA ? meta + (size_t)t * 1024 : xin + (size_t)(t - NMETA) * 1024;
#pragma unroll
            for (int j = 0; j < 4; ++j) { v[j] = ((const f32x4*)src)[lane + 64 * j]; ((f32x4*)hrow)[lane + 64 * j] = v[j]; } }
        else { const v2u* mp = (const v2u*)(Msrc + (size_t)t * 1024) + lane; f32x4 m[4]; float ss = 0.f;
#pragma unroll
            for (int j = 0; j < 4; ++j) { const v2u w = mp[64 * j]; m[j] = (f32x4){bflo(w.x), bfhi(w.x), bflo(w.y), bfhi(w.y)}; ss += (m[j].x * m[j].x + m[j].y * m[j].y) + (m[j].z * m[j].z + m[j].w * m[j].w); }
            const float rs = 1.0f / sqrtf(wave_sum(ss) * (1.f / 1024.f) + 1e-6f);
#pragma unroll
            for (int j = 0; j < 4; ++j) { const f32x4 g = ((const f32x4*)ga)[lane + 64 * j]; const f32x4 hv = ((const f32x4*)hrow)[lane + 64 * j]; v[j] = hv + m[j] * rs * g; ((f32x4*)hrow)[lane + 64 * j] = v[j]; } }
        if (mode != 2) { float s2 = 0.f;
#pragma unroll
            for (int j = 0; j < 4; ++j) s2 += (v[j].x * v[j].x + v[j].y * v[j].y) + (v[j].z * v[j].z + v[j].w * v[j].w);
            const float r2 = 1.0f / sqrtf(wave_sum(s2) * (1.f / 1024.f) + 1e-6f);
#pragma unroll
            for (int j = 0; j < 4; ++j) { const f32x4 g = ((const f32x4*)gb)[lane + 64 * j]; const f32x4 o = v[j] * r2 * g; xo[64 * j] = (v2u){pk2(o.x, o.y), pk2(o.z, o.w)}; } }
    }
}
__device__ __forceinline__ void shift_rows(const bf16* Y, const float* mu, bf16* REC, bf16* Z, bf16* DP, int gw, int NGW, int lane) {
    for (int t = gw; t < LP; t += NGW) {
        const bf16* y = Y + (size_t)t * 2304; const bool hp = t > 0;
#pragma unroll 4
        for (int q = 0; q < 28; ++q) {
            const int c = q * 64 + lane; const float cur = bf2f(y[c]); const float prev = hp ? bf2f(y[c - 2304]) : 0.f;
            const float s = cur + (prev - cur) * mu[c];
            if (q < 24) { if (t < TP) { const int vec = q >> 3, hh = q & 7; const int slot = vec == 0 ? 0 : (vec == 1 ? 2 : 3); REC[(((size_t)hh * TP + t) * 7 + slot) * 64 + lane] = (bf16)f2bf(s); } }
            else { float z; if (q == 24) z = tanhf(s); else if (q == 25) z = s; else z = 1.f / (1.f + __expf(-s)); Z[(size_t)t * 256 + (c - 1536)] = (bf16)f2bf(z); }
        }
        for (int q = 0; q < 8; ++q) { const int c = q * 64 + lane; const int win = 2 << (q >> 1); const int n = (t + 1) < win ? (t + 1) : win;
            float sum = 0.f; for (int s = 0; s < n; ++s) sum += bf2f(*(y + 1792 + c - (ptrdiff_t)s * 2304));
            const float cur = bf2f(y[1792 + c]); DP[(size_t)t * 512 + c] = (bf16)f2bf(sum / (float)n - cur); }
    }
}
__device__ __forceinline__ void prep_rows(const bf16* LR, bf16* REC, float* BON, const float* w0, const float* a0, const float* k_k, const float* k_a, const float* r_k, int gw, int NGW, int lane) {
    for (int it = gw; it < TP * 8; it += NGW) {
        const int t = it >> 3, hh = it & 7, c = hh * 64 + lane;
        bf16* rec = REC + ((size_t)hh * TP + t) * 448;
        const float r = bf2f(rec[lane]), kraw = bf2f(rec[128 + lane]);
        const bf16* lr = LR + (size_t)t * 1536;
        const float lw = bf2f(lr[c]), la = bf2f(lr[512 + c]), lg = bf2f(lr[1024 + c]);
        const float nx = -(w0[c] + lw); const float sp = fmaxf(nx, 0.f) + log1pf(__expf(-fabsf(nx)));
        const float e = __expf(-sp - 0.5f);
        const float av = 1.f / (1.f + __expf(-(a0[c] + la)));
        float kk = kraw * k_k[c]; const float nrm = sqrtf(wave_sum(kk * kk)); kk = kk / fmaxf(nrm, 1e-12f);
        const float k = kraw * (1.f + (av - 1.f) * k_a[c]);
        const float bon = wave_sum(r * k * r_k[c]);
        rec[64 + lane] = (bf16)f2bf(e); rec[128 + lane] = (bf16)f2bf(k); rec[256 + lane] = (bf16)f2bf(kk); rec[320 + lane] = (bf16)f2bf(kk * av); rec[384 + lane] = (bf16)f2bf(lg);
        if (lane == 0) BON[hh * TP + t] = bon;
    }
}
__device__ __forceinline__ void scan_stage(const bf16* rec_h, int t0, LAS float* wl, int lane) {
    const v4u* src = (const v4u*)(rec_h + (size_t)t0 * 448);
#pragma unroll
    for (int q = 0; q < 7; ++q) {
        const int ci = q * 64 + lane; const v4u raw = src[ci]; const bool isw = ((ci % 56) >> 3) == 1;
        float f[8] = {bflo(raw.x), bfhi(raw.x), bflo(raw.y), bfhi(raw.y), bflo(raw.z), bfhi(raw.z), bflo(raw.w), bfhi(raw.w)};
        if (isw) {
#pragma unroll
            for (int e = 0; e < 8; ++e) f[e] = __expf(-f[e]); }
        LAS f32x4* dst = (LAS f32x4*)(wl + ci * 8);
        dst[0] = (f32x4){f[0], f[1], f[2], f[3]}; dst[1] = (f32x4){f[4], f[5], f[6], f[7]};
    }
}
__device__ __forceinline__ void scan1(const bf16* REC, float* PP, LAS float* wl, int gw, int NGW, int lane) {
    for (int task = gw; task < NCH * 8; task += NGW) {
        const int c = task >> 3, hh = task & 7; const bf16* rec_h = REC + (size_t)hh * TP * 448;
        float P[64], Q[64];
#pragma unroll
        for (int k = 0; k < 64; ++k) { P[k] = (k == lane) ? 1.f : 0.f; Q[k] = 0.f; }
        for (int t0 = c * CHT; t0 < (c + 1) * CHT; t0 += 8) {
            scan_stage(rec_h, t0, wl, lane);
#pragma unroll 1
            for (int s = 0; s < 8; ++s) {
                const LAS float* b = wl + s * 448; const float vv = b[192 + lane];
                float sp0 = 0.f, sp1 = 0.f, sq0 = 0.f, sq1 = 0.f;
#pragma unroll
                for (int k4 = 0; k4 < 16; ++k4) { const f32x4 kk = *(const LAS f32x4*)(b + 256 + 4 * k4);
                    sp0 += P[4 * k4] * kk.x; sp1 += P[4 * k4 + 1] * kk.y; sp0 += P[4 * k4 + 2] * kk.z; sp1 += P[4 * k4 + 3] * kk.w;
                    sq0 += Q[4 * k4] * kk.x; sq1 += Q[4 * k4 + 1] * kk.y; sq0 += Q[4 * k4 + 2] * kk.z; sq1 += Q[4 * k4 + 3] * kk.w; }
                const float sap = -(sp0 + sp1), saq = -(sq0 + sq1);
#pragma unroll
                for (int k4 = 0; k4 < 16; ++k4) { const f32x4 w = *(const LAS f32x4*)(b + 64 + 4 * k4), bb = *(const LAS f32x4*)(b + 320 + 4 * k4), kv = *(const LAS f32x4*)(b + 128 + 4 * k4);
#pragma unroll
                    for (int e = 0; e < 4; ++e) { P[4 * k4 + e] = P[4 * k4 + e] * w[e] + sap * bb[e]; Q[4 * k4 + e] = Q[4 * k4 + e] * w[e] + (saq * bb[e] + vv * kv[e]); } }
            }
        }
        f32x4* po = (f32x4*)(PP + ((size_t)task * 2) * 4096 + (size_t)lane * 64); f32x4* qo = po + 1024;
#pragma unroll
        for (int k4 = 0; k4 < 16; ++k4) { po[k4] = (f32x4){P[4 * k4], P[4 * k4 + 1], P[4 * k4 + 2], P[4 * k4 + 3]}; qo[k4] = (f32x4){Q[4 * k4], Q[4 * k4 + 1], Q[4 * k4 + 2], Q[4 * k4 + 3]}; }
    }
}
__device__ __forceinline__ void scan2(float* PP, int hh, LAS float* sb, int tid, int wave, int lane) {
    const int lr = lane & 15, lq = lane >> 4, jb = wave >> 1, i0 = (wave & 1) * 2;
    for (int u = tid; u < 2 * 64 * 68; u += 512) sb[u] = 0.f;
    __syncthreads();
    float bfr[16]; f32x4 acc[2];
    { const float* Phi = PP + ((size_t)hh * 2) * 4096; const float* Psi = Phi + 4096;
#pragma unroll
      for (int kk = 0; kk < 16; ++kk) bfr[kk] = Phi[(4 * kk + lq) * 64 + 16 * jb + lr];
#pragma unroll
      for (int ii = 0; ii < 2; ++ii)
#pragma unroll
          for (int r = 0; r < 4; ++r) acc[ii][r] = Psi[(16 * (i0 + ii) + 4 * lq + r) * 64 + 16 * jb + lr]; }
    int cur = 0;
    for (int c = 0; c < NCH - 1; ++c) {
        float nb[16]; f32x4 nacc[2]; const bool more = (c + 1) < NCH - 1;
        { const float* Phi = PP + ((size_t)((more ? c + 1 : c) * 8 + hh) * 2) * 4096; const float* Psi = Phi + 4096;
#pragma unroll
          for (int kk = 0; kk < 16; ++kk) nb[kk] = Phi[(4 * kk + lq) * 64 + 16 * jb + lr];
#pragma unroll
          for (int ii = 0; ii < 2; ++ii)
#pragma unroll
              for (int r = 0; r < 4; ++r) nacc[ii][r] = more ? Psi[(16 * (i0 + ii) + 4 * lq + r) * 64 + 16 * jb + lr] : 0.f; }
        const LAS float* S = sb + cur * 64 * 68;
#pragma unroll
        for (int kk = 0; kk < 16; ++kk)
#pragma unroll
            for (int ii = 0; ii < 2; ++ii) { const float av = S[(16 * (i0 + ii) + lr) * 68 + 4 * kk + lq]; acc[ii] = __builtin_amdgcn_mfma_f32_16x16x4f32(av, bfr[kk], acc[ii], 0, 0, 0); }
        LAS float* Sn = sb + (cur ^ 1) * 64 * 68; float* So = PP + ((size_t)(c * 8 + hh) * 2 + 1) * 4096;
#pragma unroll
        for (int ii = 0; ii < 2; ++ii)
#pragma unroll
            for (int r = 0; r < 4; ++r) { const int row = 16 * (i0 + ii) + 4 * lq + r, col = 16 * jb + lr; Sn[row * 68 + col] = acc[ii][r]; So[row * 64 + col] = acc[ii][r]; }
        __syncthreads(); cur ^= 1;
#pragma unroll
        for (int kk = 0; kk < 16; ++kk) bfr[kk] = nb[kk];
        acc[0] = nacc[0]; acc[1] = nacc[1];
    }
}
__device__ __forceinline__ void scan3(const bf16* REC, const float* PP, const float* BON, const float* ln_w, const float* ln_b, bf16* OZ, LAS float* wl, int gw, int NGW, int lane) {
    for (int task = gw; task < NCH * 8; task += NGW) {
        const int c = task >> 3, hh = task & 7; const bf16* rec_h = REC + (size_t)hh * TP * 448;
        float S[64];
        if (c > 0) { const f32x4* sp = (const f32x4*)(PP + ((size_t)((c - 1) * 8 + hh) * 2 + 1) * 4096 + (size_t)lane * 64);
#pragma unroll
            for (int k4 = 0; k4 < 16; ++k4) { const f32x4 x = sp[k4]; S[4 * k4] = x.x; S[4 * k4 + 1] = x.y; S[4 * k4 + 2] = x.z; S[4 * k4 + 3] = x.w; } }
        else {
#pragma unroll
            for (int k = 0; k < 64; ++k) S[k] = 0.f; }
        const float lnw = ln_w[hh * 64 + lane], lnb = ln_b[hh * 64 + lane];
        for (int t0 = c * CHT; t0 < (c + 1) * CHT; t0 += 8) {
            scan_stage(rec_h, t0, wl, lane);
#pragma unroll 1
            for (int s = 0; s < 8; ++s) {
                const LAS float* b = wl + s * 448; const float vv = b[192 + lane], gg = b[384 + lane];
                float s0 = 0.f, s1 = 0.f;
#pragma unroll
                for (int k4 = 0; k4 < 16; ++k4) { const f32x4 kk = *(const LAS f32x4*)(b + 256 + 4 * k4);
                    s0 += S[4 * k4] * kk.x; s1 += S[4 * k4 + 1] * kk.y; s0 += S[4 * k4 + 2] * kk.z; s1 += S[4 * k4 + 3] * kk.w; }
                const float sa = -(s0 + s1); float o0 = 0.f, o1 = 0.f;
#pragma unroll
                for (int k4 = 0; k4 < 16; ++k4) { const f32x4 w = *(const LAS f32x4*)(b + 64 + 4 * k4), bb = *(const LAS f32x4*)(b + 320 + 4 * k4), kv = *(const LAS f32x4*)(b + 128 + 4 * k4), rr = *(const LAS f32x4*)(b + 4 * k4);
#pragma unroll
                    for (int e = 0; e < 4; ++e) S[4 * k4 + e] = S[4 * k4 + e] * w[e] + (sa * bb[e] + vv * kv[e]);
                    o0 += S[4 * k4] * rr.x; o1 += S[4 * k4 + 1] * rr.y; o0 += S[4 * k4 + 2] * rr.z; o1 += S[4 * k4 + 3] * rr.w; }
                const float o = o0 + o1; const int t = t0 + s;
                const float mean = wave_sum(o) * (1.f / 64.f); const float d = o - mean; const float var = wave_sum(d * d) * (1.f / 64.f);
                const float y = d * (1.0f / sqrtf(var + 64e-5f)) * lnw + lnb;
                const float res = (y + BON[hh * TP + t] * vv) * gg;
                OZ[(size_t)t * 1024 + hh * 64 + lane] = (bf16)f2bf(res);
            }
        }
    }
}
__device__ __forceinline__ void rope_rows(bf16* Qb, bf16* Kb, int gw, int NGW, int lane) {
    const int jx = lane & 31; const float inv = __expf(-(float)jx * (9.210340371976184f / 32.f));
    for (int t = gw; t < LP; t += NGW) {
        const float ang = (float)t * inv; const double rev = (double)ang * 0.15915494309189535; const float fr = (float)(rev - __builtin_rint(rev));
        const float cs = __builtin_amdgcn_cosf(fr), sn = __builtin_amdgcn_sinf(fr);
#pragma unroll
        for (int i = 0; i < 8; ++i) { const int base = ((lane >> 5) + 2 * i) * 64 + jx;
            bf16* qp = Qb + (size_t)t * 1024 + base; bf16* kp = Kb + (size_t)t * 1024 + base;
            const float q1 = bf2f(qp[0]), q2 = bf2f(qp[32]), k1 = bf2f(kp[0]), k2 = bf2f(kp[32]);
            qp[0] = (bf16)f2bf((q1 * cs - q2 * sn) * C2Q); qp[32] = (bf16)f2bf((q2 * cs + q1 * sn) * C2Q);
            kp[0] = (bf16)f2bf(k1 * cs - k2 * sn); kp[32] = (bf16)f2bf(k2 * cs + k1 * sn); }
    }
}
__device__ __forceinline__ void combine_rows(const bf16* O0, const bf16* O1, const float* lamv, const float* subw, float lam_init, bf16* OZ, int gw, int NGW, int lane) {
    const float d01 = wave_sum(lamv[lane] * lamv[64 + lane]), d23 = wave_sum(lamv[128 + lane] * lamv[192 + lane]);
    const float lam = __expf(d01) - __expf(d23) + lam_init; const float post = 1.f - lam_init;
    float sw[16];
#pragma unroll
    for (int k = 0; k < 16; ++k) sw[k] = subw[((lane & 7) * 16) + k] * post;
    for (int t = gw; t < LP; t += NGW) {
        const v4u* p0 = (const v4u*)(O0 + (size_t)t * 1024 + lane * 16); const v4u* p1 = (const v4u*)(O1 + (size_t)t * 1024 + lane * 16);
        float o[16]; float ss = 0.f;
#pragma unroll
        for (int h2 = 0; h2 < 2; ++h2) { const v4u a = p0[h2], b = p1[h2];
            const unsigned aw[4] = {a.x, a.y, a.z, a.w}, bw[4] = {b.x, b.y, b.z, b.w};
#pragma unroll
            for (int e = 0; e < 4; ++e) { o[h2 * 8 + 2 * e] = bflo(aw[e]) - lam * bflo(bw[e]); o[h2 * 8 + 2 * e + 1] = bfhi(aw[e]) - lam * bfhi(bw[e]); } }
#pragma unroll
        for (int k = 0; k < 16; ++k) ss += o[k] * o[k];
        ss += __shfl_xor(ss, 1); ss += __shfl_xor(ss, 2); ss += __shfl_xor(ss, 4);
        const float rs = 1.0f / sqrtf(ss * (1.f / 128.f) + 1e-5f);
        v4u w0, w1;
        w0.x = pk2(o[0] * rs * sw[0], o[1] * rs * sw[1]); w0.y = pk2(o[2] * rs * sw[2], o[3] * rs * sw[3]); w0.z = pk2(o[4] * rs * sw[4], o[5] * rs * sw[5]); w0.w = pk2(o[6] * rs * sw[6], o[7] * rs * sw[7]);
        w1.x = pk2(o[8] * rs * sw[8], o[9] * rs * sw[9]); w1.y = pk2(o[10] * rs * sw[10], o[11] * rs * sw[11]); w1.z = pk2(o[12] * rs * sw[12], o[13] * rs * sw[13]); w1.w = pk2(o[14] * rs * sw[14], o[15] * rs * sw[15]);
        v4u* po = (v4u*)(OZ + (size_t)t * 1024 + lane * 16); po[0] = w0; po[1] = w1;
    }
}
#define INP(i) inp_ptr(a, (i))
__global__ void __launch_bounds__(NWAVES * 64, 2) mega_fwd(Args a) {
    extern __shared__ __attribute__((aligned(16))) unsigned char lds[];
    cg::grid_group grid = cg::this_grid();
    LAS unsigned char* ldsl = (LAS unsigned char*)lds;
    const int wave0 = __builtin_amdgcn_readfirstlane(threadIdx.x >> 6);
#pragma unroll 1
    for (int p = a.ph_lo; p < a.ph_hi; ++p) {
        unsigned zs = 0u; asm volatile("" : "+s"(zs));
        const int tid = wave0 * 64 + (int)__builtin_amdgcn_mbcnt_hi(~0u, __builtin_amdgcn_mbcnt_lo(~0u, zs));
        int G = gridDim.x, bx = blockIdx.x; asm volatile("" : "+s"(G), "+s"(bx));
        unsigned char* ws = a.ws; asm volatile("" : "+s"(ws));
        const int lane = tid & 63, wave = __builtin_amdgcn_readfirstlane(tid >> 6);
        const int vcu = (G % 8 == 0) ? (bx % 8) * (G / 8) + bx / 8 : bx;
        const int gw = vcu * NWAVES + wave, NGW = G * NWAVES, gtid = bx * (NWAVES * 64) + tid, NTHR = G * NWAVES * 64;
        LAS float* wl = (LAS float*)(ldsl + wave * 16384);
        bf16* XN = (bf16*)(ws + WS_XN);
        int layer, step;
        if (p < 12) { layer = 0; step = p; } else if (p < 21) { layer = 1; step = p - 12; } else if (p < 33) { layer = 2; step = p - 21; } else if (p < 42) { layer = 3; step = p - 33; } else { layer = 4; step = 0; }
        const bool odd = layer & 1; const int j = layer >> 1;
        const float* ng = INP(2) + (size_t)layer * 4096;
        int kind;
        if (layer == 4) kind = 0;
        else if (!odd) kind = (step == 0 || step == 9) ? 0 : (step == 2) ? 2 : (step == 4) ? 3 : (step == 5) ? 4 : (step == 6) ? 5 : (step == 7) ? 6 : 1;
        else kind = (step == 0 || step == 6) ? 0 : (step == 2) ? 7 : (step == 3) ? 8 : (step == 4) ? 9 : 1;
        if (kind == 0) {
            if (layer == 4) norm_rows(2, nullptr, nullptr, a.out, (float*)(ws + WS_HM), (const bf16*)(ws + WS_F), ng - 1024, nullptr, XN, gw, NGW, lane);
            else if (step == 0) {
                wconv(a, layer, wl, gw, NGW, lane, gtid, NTHR);
                if (layer == 0) norm_rows(0, INP(0), INP(1), a.out, (float*)(ws + WS_HM), nullptr, nullptr, ng, XN, gw, NGW, lane);
                else norm_rows(1, nullptr, nullptr, a.out, (float*)(ws + WS_HM), (const bf16*)(ws + WS_F), ng - 1024, ng, XN, gw, NGW, lane);
            } else norm_rows(1, nullptr, nullptr, a.out, (float*)(ws + WS_HM), (const bf16*)(ws + (odd ? WS_M1O : WS_M1E)), ng + 1024, ng + 2048, XN, gw, NGW, lane);
        } else if (kind == 1) {
            int ng_ = 1;
            const bf16* A0 = XN; const bf16* B0 = (const bf16*)(ws + WS_WIN); int N0 = 2304, K0 = 1024, ldc0 = 2304, act0 = 0, sc0 = 0; bf16* O0 = (bf16*)(ws + WS_Y); const float* cs0 = nullptr;
            const bf16* A1 = nullptr; const bf16* B1 = nullptr; int N1 = 0, K1 = 0, ldc1 = 0; bf16* O1 = nullptr; const float* cs1 = nullptr;
            if (!odd) {
                if (step == 3) { ng_ = 2; A0 = (const bf16*)(ws + WS_Z); B0 = (const bf16*)(ws + WS_WLR); N0 = 1536; K0 = 256; ldc0 = 1536; O0 = (bf16*)(ws + WS_LR);
                                 A1 = (const bf16*)(ws + WS_DP); B1 = (const bf16*)(ws + WS_WPOOL); N1 = 512; K1 = 512; ldc1 = 1024; O1 = (bf16*)(ws + WS_OZE) + 512; cs1 = INP(18) + (size_t)j * 512; }
                else if (step == 8) { A0 = (const bf16*)(ws + WS_OZE); B0 = (const bf16*)(ws + WS_WOUT); N0 = 1024; ldc0 = 1024; O0 = (bf16*)(ws + WS_M1E); }
            } else {
                if (step == 1) { N0 = 3072; ldc0 = 1024; sc0 = 1024; O0 = (bf16*)(ws + WS_Q); }
                else if (step == 5) { A0 = (const bf16*)(ws + WS_OZO); B0 = (const bf16*)(ws + WS_WOUT); N0 = 1024; ldc0 = 1024; O0 = (bf16*)(ws + WS_M1O); }
            }
            const int mstep = odd ? step - 7 : step - 10;
            if (mstep == 0) { B0 = (const bf16*)(ws + WS_W1); N0 = 4096; ldc0 = 4096; act0 = 1; O0 = (bf16*)(ws + WS_HID); }
            else if (mstep == 1) { A0 = (const bf16*)(ws + WS_HID); B0 = (const bf16*)(ws + WS_W2); N0 = 1024; K0 = 4096; ldc0 = 1024; O0 = (bf16*)(ws + WS_F); }
#pragma unroll 1
            for (int q = 0; q < ng_; ++q) {
                pg8::Gemm g{q ? A1 : A0, q ? B1 : B0, LP, q ? N1 : N0, q ? K1 : K0}; pg8::StaticOrder S; S.init(LP, g.N, G, bx);
                pg8::EpiBf16 E{q ? O1 : O0, q ? ldc1 : ldc0, q ? cs1 : cs0, q ? 0 : sc0, ACT_BYTES / 2, q ? 0 : act0};
                pg8::gemm_phase<pg8::EpiBf16, pg8::StaticOrder, true, true>(ldsl, g, S, E, tid);
            }
        } else if (kind == 2) {
            shift_rows((const bf16*)(ws + WS_Y), INP(6) + (size_t)j * 1792, (bf16*)(ws + WS_REC), (bf16*)(ws + WS_Z), (bf16*)(ws + WS_DP), gw, NGW, lane);
        } else if (kind == 3) {
            prep_rows((const bf16*)(ws + WS_LR), (bf16*)(ws + WS_REC), (float*)(ws + WS_BON), INP(7) + j * 512, INP(9) + j * 512, INP(12) + j * 512, INP(13) + j * 512, INP(14) + j * 512, gw, NGW, lane);
        } else if (kind == 4) {
            scan1((const bf16*)(ws + WS_REC), (float*)(ws + WS_PP), wl, gw, NGW, lane);
        } else if (kind == 5) {
            if (bx < 8) scan2((float*)(ws + WS_PP), bx, (LAS float*)ldsl, tid, wave, lane);
        } else if (kind == 6) {
            scan3((const bf16*)(ws + WS_REC), (const float*)(ws + WS_PP), (const float*)(ws + WS_BON), INP(15) + j * 512, INP(16) + j * 512, (bf16*)(ws + WS_OZE), wl, gw, NGW, lane);
        } else if (kind == 7) {
            rope_rows((bf16*)(ws + WS_Q), (bf16*)(ws + WS_K), gw, NGW, lane);
        } else if (kind == 8) {
            const attn_body::bf16* Qb = (const attn_body::bf16*)(ws + WS_Q); const attn_body::bf16* Kb = (const attn_body::bf16*)(ws + WS_K); const attn_body::bf16* Vb = (const attn_body::bf16*)(ws + WS_V);
            attn_body::bf16* Ob0 = (attn_body::bf16*)(ws + WS_O0); attn_body::bf16* Ob1 = (attn_body::bf16*)(ws + WS_O1);
            for (int r = 0;; ++r) {
                const int pidx = r * G + ((r & 1) ? (G - 1 - vcu) : vcu); if (pidx >= 65 * 32) break;
                const int qb = 64 - (pidx >> 5), vh = pidx & 31, hh = vh >> 2, cc = (vh >> 1) & 1, ee = vh & 1;
                int tid_u = tid; asm volatile("" : "+v"(tid_u));
                attn_body::attn_unit<8>(qb, Qb + hh * 128 + cc * 64, Kb + hh * 128 + cc * 64, Vb + hh * 128 + ee * 64, (cc ? Ob1 : Ob0) + hh * 128 + ee * 64, (char*)lds, tid_u);
            }
        } else {
            combine_rows((const bf16*)(ws + WS_O0), (const bf16*)(ws + WS_O1), INP(21) + j * 256, INP(22) + j * 128, 0.8f - 0.6f * expf(-0.3f * (float)layer), (bf16*)(ws + WS_OZO), gw, NGW, lane);
        }
        if (p + 1 < a.ph_hi) grid.sync();
    }
}

extern "C" void kernel_launch(void* const* d_in, const int* in_sizes, int n_in, void* d_out, int out_size, void* d_ws, size_t ws_size, hipStream_t stream) {
    static int grid = 0;
    if (grid == 0) {
        if (n_in != 24 || out_size != 16384 * 1024 || ws_size < WS_END) { fprintf(stderr, "kernel_launch: unexpected shapes: n_in %d out %d ws %zu; nothing launched\n", n_in, out_size, ws_size); grid = -1; return; }
        int dev = 0, cus = 0, per_cu = 0;
        if (hipGetDevice(&dev) != hipSuccess || hipDeviceGetAttribute(&cus, hipDeviceAttributeMultiprocessorCount, dev) != hipSuccess) { grid = -1; return; }
        if (hipFuncSetAttribute((const void*)mega_fwd, hipFuncAttributeMaxDynamicSharedMemorySize, LDS_BYTES) != hipSuccess) { fprintf(stderr, "kernel_launch: hipFuncSetAttribute failed\n"); grid = -1; return; }
        if (hipOccupancyMaxActiveBlocksPerMultiprocessor(&per_cu, (const void*)mega_fwd, NWAVES * 64, LDS_BYTES) != hipSuccess || per_cu < 1) { fprintf(stderr, "kernel_launch: occupancy query says %d blocks per CU\n", per_cu); per_cu = 1; }
        (void)hipGetLastError();
        grid = cus;
    }
    if (grid < 0) return;
    Args a{};
    for (int i = 0; i < 24; ++i) a.in[i] = (const float*)d_in[i];
    a.out = (float*)d_out; a.ws = (unsigned char*)d_ws;
#if MK_SINGLE
    a.ph_lo = 0; a.ph_hi = NPH;
    void* args[] = {&a};
    hipError_t e = hipLaunchCooperativeKernel((const void*)mega_fwd, dim3(grid), dim3(NWAVES * 64), args, LDS_BYTES, stream);
    if (e != hipSuccess) fprintf(stderr, "kernel_launch: cooperative launch failed: %s (grid %d)\n", hipGetErrorString(e), grid);
#else
    for (int p = 0; p < NPH; ++p) { a.ph_lo = p; a.ph_hi = p + 1; hipLaunchKernelGGL(mega_fwd, dim3(grid), dim3(NWAVES * 64), LDS_BYTES, stream, a); }
#endif
}
```

```cpp
#include <hip/hip_runtime.h>
#include <hip/hip_cooperative_groups.h>
#include <cstdio>
#include <cstdint>
namespace cg = cooperative_groups;
#define MK_SINGLE 1
#define REP_MASK 0
#define BAR_TWICE 0
namespace pg8 {
#define PG8_LAS __attribute__((address_space(3)))
typedef unsigned short bf16_t;
typedef short bf16x8 __attribute__((ext_vector_type(8)));
typedef float f32x4 __attribute__((ext_vector_type(4)));
typedef unsigned u32x4 __attribute__((ext_vector_type(4)));
constexpr int BM = 256, BK = 64, HALF = 128, HTB = HALF * BK * 2  , STAGE_BYTES = 8 * HTB, NXCD = 8, WGM = 8;

__host__ __device__ __forceinline__ int lds_byte(int r, int c) { const int st = (r >> 4) * 2 + (c >> 5), rr = r & 15, cc = c & 31, ob = rr * 64 + cc * 2; return st * 1024 + (ob ^ (((ob >> 9) & 1) << 5)); }
__host__ __device__ __forceinline__ void stage_rc(int b, int& R, int& C) { const int st = b / 1024, sb = b % 1024, swz = sb ^ (((sb >> 9) & 1) << 5); R = (st >> 1) * 16 + swz / 64; C = (st & 1) * 32 + (swz % 64) / 2; }
__host__ __device__ __forceinline__ int perm32(int rho) { const int n = rho >> 4, i = rho & 15; return 8 * (i >> 2) + 4 * n + (i & 3); }

struct Unit { int pm, pn; };
struct Gemm { const bf16_t* A; const bf16_t* Bt; int M, N, K; };

struct StaticOrder {
    int nM, nN, nwg, G, c;
    __host__ __device__ void init(int M, int N, int G_, int c_) { nM = M / BM; nN = N / BM; nwg = nM * nN; G = G_; c = c_; }
    __host__ __device__ bool next(int i, Unit& u) const {
        const long L = (long)i * G + c; if (L >= nwg) return false;
        int wgid = (int)L; { const int q = nwg / NXCD, r = nwg % NXCD, xcd = wgid % NXCD, off = wgid / NXCD; wgid = (xcd < r ? xcd * (q + 1) : r * (q + 1) + (xcd - r) * q) + off; }
        const int nig = WGM * nN, gid = wgid / nig, fm = gid * WGM, gsz = (nM - fm) < WGM ? (nM - fm) : WGM;
        u.pm = fm + ((wgid % nig) % gsz); u.pn = (wgid % nig) / gsz; return true;
    }
    __device__ __forceinline__ void a_ready(const Unit&) const {}
    __device__ __forceinline__ void done(const Unit&) const {}
};

__device__ __forceinline__ unsigned cvt_pk_bf16(float lo, float hi) { unsigned r; asm volatile("v_cvt_pk_bf16_f32 %0, %1, %2" : "=v"(r) : "v"(lo), "v"(hi)); return r; }
typedef float f32x2 __attribute__((ext_vector_type(2)));
struct EpiBf16 {
    static constexpr bool PERM = true, AFTER_DRAIN = false;
    bf16_t* O; int ldc; const float* cscale; int split_cols; size_t split_stride; int act; int rope  ; int pos_off;
    __device__ __forceinline__ void operator()(const f32x4 (&acc)[2][2][4][2], const Unit& u, int wr, int wc, int fr, int fq) const {
        const int row0 = u.pm * BM + wr * 64 + fr; int colt = u.pn * BM; bf16_t* base = O;
        int tsel = 0; if (split_cols) { const int t = colt / split_cols; base += (size_t)t * split_stride; colt -= t * split_cols; tsel = t; }
        const bool do_rope = rope && tsel < 2; const float qs = (do_rope && tsel == 0) ? 0.18033688011112042f : 1.f;
        const int col0 = colt + wc * 32 + 8 * fq, ccol0 = u.pn * BM + wc * 32 + 8 * fq;
        f32x4 sv[2][2];
#pragma unroll
        for (int bj = 0; bj < 2; ++bj)
#pragma unroll
            for (int n = 0; n < 2; ++n) sv[bj][n] = cscale ? *(const f32x4*)(cscale + ccol0 + bj * HALF + 4 * n) : (f32x4){1.f, 1.f, 1.f, 1.f};
#pragma unroll
        for (int ai = 0; ai < 2; ++ai)
#pragma unroll
            for (int m = 0; m < 4; ++m) { bf16_t* rowp = base + (size_t)(row0 + ai * HALF + m * 16) * ldc + col0;
#pragma unroll
                for (int bj = 0; bj < 2; ++bj) { f32x4 v0 = acc[ai][bj][m][0], v1 = acc[ai][bj][m][1];
                    if (do_rope) { const float pos = (float)(row0 + ai * HALF + m * 16 + pos_off); const int j0 = ((col0 + bj * HALF) & 63) >> 1;
#pragma unroll
                        for (int e2 = 0; e2 < 4; ++e2) { const float inv = expf(-(float)(j0 + e2) * (9.210340371976184f / 32.f)); const float ang = pos * inv; const double rev = (double)ang * 0.15915494309189535; const float fr_ = (float)(rev - __builtin_rint(rev));
                            const float cs = __builtin_amdgcn_cosf(fr_) * qs, sn = __builtin_amdgcn_sinf(fr_) * qs;
                            if (e2 < 2) { const float x1 = v0[2 * e2], x2 = v0[2 * e2 + 1]; v0[2 * e2] = x1 * cs - x2 * sn; v0[2 * e2 + 1] = x2 * cs + x1 * sn; }
                            else { const float x1 = v1[2 * e2 - 4], x2 = v1[2 * e2 - 3]; v1[2 * e2 - 4] = x1 * cs - x2 * sn; v1[2 * e2 - 3] = x2 * cs + x1 * sn; } } }
                    if (act == 1) {
#pragma unroll
                        for (int e = 0; e < 4; ++e) { const float a = fmaxf(v0[e], 0.f), b = fmaxf(v1[e], 0.f); v0[e] = a * a; v1[e] = b * b; } }
                    v0 = v0 * sv[bj][0]; v1 = v1 * sv[bj][1]; u32x4 w; w.x = cvt_pk_bf16(v0[0], v0[1]); w.y = cvt_pk_bf16(v0[2], v0[3]); w.z = cvt_pk_bf16(v1[0], v1[1]); w.w = cvt_pk_bf16(v1[2], v1[3]);
                    *(u32x4*)(rowp + bj * HALF) = w; } }
    }
};
template <class Epi, class Sched, bool ALIGN_EPI = false, bool SP2 = false>
__device__ __forceinline__ void gemm_phase(PG8_LAS unsigned char* lds, const Gemm g, const Sched& S, const Epi& E, const int tid) {
    const int wid = __builtin_amdgcn_readfirstlane(tid >> 6), lane = tid & 63, wr = wid >> 2, wc = wid & 3, fr = lane & 15, fq = lane >> 4;
    const int K = g.K, nt = K / BK;
    unsigned voffA[2], voffB[2];
#pragma unroll
    for (int i = 0; i < 2; ++i) { int R, C; stage_rc(tid * 16 + i * 8192, R, C); const int Rb = Epi::PERM ? ((R & ~31) + perm32(R & 31)) : R;
        voffA[i] = (unsigned)(R * K + C) * 2u; voffB[i] = (unsigned)(Rb * K + C) * 2u; }
    const size_t kstep = (size_t)(BK * 2);
    const size_t hstep = (size_t)HALF * K * 2;
    const size_t tstep = 2 * hstep;
    const unsigned ldsw = (unsigned)wid * 1024u;
    const int aoff = lds_byte(wr * 64 + fr, fq * 8), boff = lds_byte(wc * 32 + fr, fq * 8);
#define PG8_SA(b, h) (((b) * 2 + (h)) * HTB)
#define PG8_SB(b, h) ((4 + (b) * 2 + (h)) * HTB)
#define PG8_STAGE(bufoff, gbase, voff) do { _Pragma("unroll") for (int _i = 0; _i < 2; ++_i) \
        __builtin_amdgcn_global_load_lds((const unsigned*)((const char*)(gbase) + (voff)[_i]), (PG8_LAS unsigned*)(lds + (bufoff) + ldsw + _i * 8192), 16, 0, 0); } while (0)
#define PG8_LDA(dst, b, h) do { _Pragma("unroll") for (int m = 0; m < 4; ++m) _Pragma("unroll") for (int k = 0; k < 2; ++k) dst[m][k] = *(const PG8_LAS bf16x8*)(lds + PG8_SA(b, h) + aoff + m * 2048 + k * 1024); } while (0)
#define PG8_LDB(dst, b, h) do { _Pragma("unroll") for (int n = 0; n < 2; ++n) _Pragma("unroll") for (int k = 0; k < 2; ++k) dst[n][k] = *(const PG8_LAS bf16x8*)(lds + PG8_SB(b, h) + boff + n * 2048 + k * 1024); } while (0)
#define PG8_MMA(ai, bj, At, Bt) do { __builtin_amdgcn_s_setprio(1); _Pragma("unroll") for (int m = 0; m < 4; ++m) _Pragma("unroll") for (int n = 0; n < 2; ++n) _Pragma("unroll") for (int k = 0; k < 2; ++k) \
        acc[ai][bj][m][n] = __builtin_amdgcn_mfma_f32_16x16x32_bf16(Bt[n][k], At[m][k], acc[ai][bj][m][n], 0, 0, 0); __builtin_amdgcn_s_setprio(0); } while (0)
#define PG8_WAIT_V(n) asm volatile("s_waitcnt vmcnt(" #n ")" ::: "memory")
#define PG8_WAIT_L(n) asm volatile("s_waitcnt lgkmcnt(" #n ")" ::: "memory")
#define PG8_BAR __builtin_amdgcn_s_barrier()
#define PG8_SCHED __builtin_amdgcn_sched_barrier(0)
    Unit cur, nxt; int ui = 0;
    if (!S.next(0, cur)) return;
    f32x4 acc[2][2][4][2];
#pragma unroll
    for (int a = 0; a < 2; ++a)
#pragma unroll
        for (int b = 0; b < 2; ++b)
#pragma unroll
            for (int m = 0; m < 4; ++m)
#pragma unroll
                for (int n = 0; n < 2; ++n) acc[a][b][m][n] = (f32x4){0.f, 0.f, 0.f, 0.f};
    bf16x8 At[4][2], B0[2][2], B1[2][2];
    const char* cA = (const char*)g.A + (size_t)cur.pm * tstep; const char* cB = (const char*)g.Bt + (size_t)cur.pn * tstep;
    S.a_ready(cur);
    if constexpr (SP2) {
        PG8_STAGE(PG8_SB(0, 0), cB, voffB); PG8_STAGE(PG8_SB(0, 1), cB + hstep, voffB); PG8_STAGE(PG8_SA(0, 0), cA, voffA); PG8_STAGE(PG8_SA(0, 1), cA + hstep, voffA);
        if (wr == 1) PG8_BAR;
        PG8_WAIT_V(2); PG8_BAR;
        PG8_STAGE(PG8_SB(1, 0), cB + kstep, voffB); PG8_STAGE(PG8_SA(1, 0), cA + kstep, voffA); PG8_STAGE(PG8_SB(1, 1), cB + hstep + kstep, voffB);
        PG8_WAIT_V(6); PG8_BAR;
    } else {
        PG8_STAGE(PG8_SB(0, 0), cB, voffB); PG8_STAGE(PG8_SA(0, 0), cA, voffA); PG8_STAGE(PG8_SB(0, 1), cB + hstep, voffB); PG8_STAGE(PG8_SA(0, 1), cA + hstep, voffA);
        if (wr == 1) PG8_BAR;
        PG8_WAIT_V(4); PG8_BAR;
        PG8_STAGE(PG8_SB(1, 0), cB + kstep, voffB); PG8_STAGE(PG8_SA(1, 0), cA + kstep, voffA); PG8_STAGE(PG8_SB(1, 1), cB + hstep + kstep, voffB);
        PG8_WAIT_V(6); PG8_BAR;
    }
    for (;;) {
        const bool has_next = S.next(ui + 1, nxt);
        const char* nA = has_next ? (const char*)g.A + (size_t)nxt.pm * tstep : cA; const char* nB = has_next ? (const char*)g.Bt + (size_t)nxt.pn * tstep : cB;
        for (int t = 0; t < nt; t += 2) {
            const bool last = (t == nt - 2);
            const char* a1 = cA + (size_t)(t + 1) * kstep;
            const char* a2 = last ? nA : cA + (size_t)(t + 2) * kstep; const char* b2 = last ? nB : cB + (size_t)(t + 2) * kstep;
            const char* a3 = a2 + kstep; const char* b3 = b2 + kstep;
            if (last && has_next) S.a_ready(nxt);
            if constexpr (SP2) {
            PG8_LDB(B0, 0, 0); PG8_LDB(B1, 0, 1); PG8_SCHED; PG8_LDA(At, 0, 0); PG8_STAGE(PG8_SA(1, 1), a1 + hstep, voffA);
            PG8_WAIT_V(8); PG8_WAIT_L(0); PG8_BAR; PG8_MMA(0, 0, At, B0); PG8_MMA(0, 1, At, B1); PG8_BAR; PG8_SCHED;
            PG8_LDA(At, 0, 1); PG8_STAGE(PG8_SB(0, 0), b2, voffB); PG8_STAGE(PG8_SB(0, 1), b2 + hstep, voffB); PG8_STAGE(PG8_SA(0, 0), a2, voffA);
            PG8_WAIT_V(8); PG8_WAIT_L(0); PG8_BAR; PG8_MMA(1, 0, At, B0); PG8_MMA(1, 1, At, B1); PG8_BAR; PG8_SCHED;
            PG8_LDB(B0, 1, 0); PG8_LDB(B1, 1, 1); PG8_SCHED; PG8_LDA(At, 1, 0); PG8_STAGE(PG8_SA(0, 1), a2 + hstep, voffA);
            PG8_WAIT_V(8); PG8_WAIT_L(0); PG8_BAR; PG8_MMA(0, 0, At, B0); PG8_MMA(0, 1, At, B1); PG8_BAR; PG8_SCHED;
            PG8_LDA(At, 1, 1); PG8_STAGE(PG8_SB(1, 0), b3, voffB); PG8_STAGE(PG8_SB(1, 1), b3 + hstep, voffB); PG8_STAGE(PG8_SA(1, 0), a3, voffA);
            PG8_WAIT_V(8); PG8_WAIT_L(0); PG8_BAR; PG8_MMA(1, 0, At, B0); PG8_MMA(1, 1, At, B1); PG8_BAR; PG8_SCHED;
            } else {
            PG8_LDB(B0, 0, 0); PG8_SCHED; PG8_LDA(At, 0, 0); PG8_STAGE(PG8_SA(1, 1), a1 + hstep, voffA);
            PG8_WAIT_L(8); PG8_BAR; PG8_WAIT_L(0); PG8_MMA(0, 0, At, B0); PG8_BAR; PG8_SCHED;
            PG8_LDB(B1, 0, 1); PG8_STAGE(PG8_SB(0, 0), b2, voffB);
            PG8_BAR; PG8_WAIT_L(0); PG8_MMA(0, 1, At, B1); PG8_BAR;
            PG8_LDA(At, 0, 1); PG8_STAGE(PG8_SA(0, 0), a2, voffA);
            PG8_BAR; PG8_WAIT_L(0); PG8_MMA(1, 0, At, B0); PG8_BAR; PG8_SCHED;
            PG8_STAGE(PG8_SB(0, 1), b2 + hstep, voffB);
            PG8_WAIT_V(6); PG8_BAR; PG8_MMA(1, 1, At, B1); PG8_BAR;
            PG8_LDB(B0, 1, 0); PG8_SCHED; PG8_LDA(At, 1, 0); PG8_STAGE(PG8_SA(0, 1), a2 + hstep, voffA);
            PG8_WAIT_L(8); PG8_BAR; PG8_WAIT_L(0); PG8_MMA(0, 0, At, B0); PG8_BAR; PG8_SCHED;
            PG8_LDB(B1, 1, 1); PG8_STAGE(PG8_SB(1, 0), b3, voffB);
            PG8_BAR; PG8_WAIT_L(0); PG8_MMA(0, 1, At, B1); PG8_BAR;
            PG8_LDA(At, 1, 1); PG8_STAGE(PG8_SA(1, 0), a3, voffA);
            PG8_BAR; PG8_WAIT_L(0); PG8_MMA(1, 0, At, B0); PG8_BAR; PG8_SCHED;
            PG8_STAGE(PG8_SB(1, 1), b3 + hstep, voffB);
            PG8_WAIT_V(6); PG8_BAR; PG8_MMA(1, 1, At, B1); PG8_BAR;
            }
        }
        if constexpr (ALIGN_EPI) { if (wr == 0) PG8_BAR; }
        if constexpr (!Epi::AFTER_DRAIN) { E(acc, cur, wr, wc, fr, fq); S.done(cur); }
        if (!has_next) break;
#pragma unroll
        for (int a = 0; a < 2; ++a)
#pragma unroll
            for (int b = 0; b < 2; ++b)
#pragma unroll
                for (int m = 0; m < 4; ++m)
#pragma unroll
                    for (int n = 0; n < 2; ++n) acc[a][b][m][n] = (f32x4){0.f, 0.f, 0.f, 0.f};
        cur = nxt; cA = nA; cB = nB; ++ui;
        if constexpr (ALIGN_EPI) { if (wr == 1) PG8_BAR; }
    }
    PG8_WAIT_V(0);
    if constexpr (!ALIGN_EPI) { if (wr == 0) PG8_BAR; }
    PG8_BAR;
    if constexpr (Epi::AFTER_DRAIN) { E.fused(acc, cur, wr, wc, fr, fq, lds, wid, lane); S.done(cur); }
#undef PG8_SA
#undef PG8_SB
#undef PG8_STAGE
#undef PG8_LDA
#undef PG8_LDB
#undef PG8_MMA
#undef PG8_WAIT_V
#undef PG8_WAIT_L
#undef PG8_BAR
#undef PG8_SCHED
}
}
#include <hip/hip_bf16.h>
#include <cmath>
namespace attn_body {
using bf16=__hip_bfloat16;
using bf16x8=__attribute__((ext_vector_type(8)))short;
using s16x4=__attribute__((ext_vector_type(4)))short;
using f32x16=__attribute__((ext_vector_type(16)))float;
using u32x4=__attribute__((ext_vector_type(4)))unsigned;
typedef float f32x4_t __attribute__((ext_vector_type(4)));
constexpr int D=64,DM=1024;
constexpr int NW=8,QBLK=32,QB=QBLK*NW,KVBLK=64;
constexpr int ATTN_PITCH=DM, ATTN_UNIT_ROWS=QB;
__device__ __forceinline__ int crow(int r,int hi){return (r&3)+8*(r>>2)+4*hi;}
#define SBAR() __builtin_amdgcn_sched_barrier(0)
__device__ __forceinline__ void cmask(f32x16&p0,f32x16&p1,int jb,int qrel,int hi){
  const float NEG=-INFINITY; int kb=64*jb+4*hi;
  #pragma unroll
  for(int r=0;r<16;++r){int kv=kb+(r&3)+8*(r>>2); if(kv>qrel)p0[r]=NEG; if(kv+32>qrel)p1[r]=NEG;}
}

constexpr int NSLOT=3, SLOTB=8192;
constexpr int LDS_K=0, LDS_V=NSLOT*SLOTB, LDS_V1=2*NSLOT*SLOTB, LDS_WS=3*NSLOT*SLOTB, LDS_QS=LDS_WS+NW*64*4, LDS_OST=LDS_V, LDS_BYTES=LDS_QS+NW*4096;
constexpr float C2=0.125f*1.4426950408889634f;
__device__ __forceinline__ void glds16(const void*gsrc,unsigned lds_dst){unsigned keep;
  asm volatile("s_mov_b32 %0, m0\n\ts_mov_b32 m0, %2\n\ts_nop 0\n\tglobal_load_lds_dwordx4 %1, off\n\ts_mov_b32 m0, %0":"=&s"(keep):"v"(gsrc),"s"(lds_dst):"memory");}
__device__ __forceinline__ float max3f(float a,float b,float c){float r;asm("v_max3_f32 %0, %1, %2, %3":"=v"(r):"v"(a),"v"(b),"v"(c));return r;}
__device__ __forceinline__ float max2f(float a,float b){float r;asm("v_max_f32_e32 %0, %1, %2":"=v"(r):"v"(a),"v"(b));return r;}
__device__ __forceinline__ float fadd_s(float a,float b){float r;asm("v_add_f32_e32 %0, %1, %2":"=v"(r):"v"(a),"v"(b));return r;}
__device__ __forceinline__ float fsub_s(float a,float b){float r;asm("v_sub_f32_e32 %0, %1, %2":"=v"(r):"v"(a),"v"(b));return r;}
typedef float f32x2_t __attribute__((ext_vector_type(2))); typedef __bf16 bf16x2_t __attribute__((ext_vector_type(2)));
__device__ __forceinline__ unsigned cvtpk_s(float lo,float hi){f32x2_t v={lo,hi};bf16x2_t b=__builtin_convertvector(v,bf16x2_t);return __builtin_bit_cast(unsigned,b);}
#define WAIT_BAR(N) asm volatile("s_waitcnt vmcnt(" #N ") lgkmcnt(0)\n\ts_barrier":::"memory")

__device__ __forceinline__ void qkt(f32x16&p0,f32x16&p1,const char*Kslot,const bf16x8*qr,const f32x16&negm,int r32,int hi){
  const char*kb=Kslot+hi*1024+r32*16;
  #pragma unroll
  for(int d0=0;d0<4;++d0){
    const bf16x8 b0=*reinterpret_cast<const bf16x8*>(kb+d0*2048);
    const bf16x8 b1=*reinterpret_cast<const bf16x8*>(kb+d0*2048+512);
    if(d0==0){p0=__builtin_amdgcn_mfma_f32_32x32x16_bf16(b0,qr[0],negm,0,0,0);p1=__builtin_amdgcn_mfma_f32_32x32x16_bf16(b1,qr[0],negm,0,0,0);}
    else{p0=__builtin_amdgcn_mfma_f32_32x32x16_bf16(b0,qr[d0],p0,0,0,0);p1=__builtin_amdgcn_mfma_f32_32x32x16_bf16(b1,qr[d0],p1,0,0,0);}}
}
typedef __attribute__((address_space(3))) const char* lds_cptr;
typedef short v4i16_t __attribute__((ext_vector_type(4)));
__device__ __forceinline__ void kload8(bf16x8*kf,lds_cptr kp){
  kf[0]=*(const __attribute__((address_space(3))) bf16x8*)(kp);      kf[1]=*(const __attribute__((address_space(3))) bf16x8*)(kp+512);
  kf[2]=*(const __attribute__((address_space(3))) bf16x8*)(kp+2048); kf[3]=*(const __attribute__((address_space(3))) bf16x8*)(kp+2560);
  kf[4]=*(const __attribute__((address_space(3))) bf16x8*)(kp+4096); kf[5]=*(const __attribute__((address_space(3))) bf16x8*)(kp+4608);
  kf[6]=*(const __attribute__((address_space(3))) bf16x8*)(kp+6144); kf[7]=*(const __attribute__((address_space(3))) bf16x8*)(kp+6656);
}
__device__ __forceinline__ void kload2(bf16x8*kf,lds_cptr kp,int j){ kf[2*j]=*(const __attribute__((address_space(3))) bf16x8*)(kp+j*2048); kf[2*j+1]=*(const __attribute__((address_space(3))) bf16x8*)(kp+j*2048+512); }
__device__ __forceinline__ s16x4 vtr(lds_cptr p){ return __builtin_bit_cast(s16x4,__builtin_amdgcn_ds_read_tr16_b64_v4i16((__attribute__((address_space(3))) v4i16_t*)p)); }
__device__ __forceinline__ float rowmax(const f32x16&p0,const f32x16&p1){
  float a=max3f(p0[0],p0[1],p1[0]),b=max3f(p0[2],p0[3],p1[1]);a=max3f(a,p1[2],p1[3]);
  #pragma unroll
  for(int r=4;r<16;r+=4){a=max3f(a,p0[r],p0[r+1]);b=max3f(b,p0[r+2],p0[r+3]);a=max3f(a,p1[r],p1[r+1]);b=max3f(b,p1[r+2],p1[r+3]);}
  const float m=max2f(a,b);
  auto rr=__builtin_amdgcn_permlane32_swap(__float_as_uint(m),__float_as_uint(m),false,false);
  return max2f(__uint_as_float(rr[0]),__uint_as_float(rr[1]));
}
__device__ __forceinline__ void pv(f32x16*o,int vb,bf16x8 pa0,bf16x8 pa1,bf16x8 pa2,bf16x8 pa3){
  #pragma unroll
  for(int d0=0;d0<2;++d0){s16x4 lo[4],hi[4];
    #pragma unroll
    for(int ks=0;ks<4;++ks){
      asm volatile("ds_read_b64_tr_b16 %0,%1 offset:%c2":"=&v"(lo[ks]):"v"(vb),"i"(d0*4096+ks*1024):"memory");
      asm volatile("ds_read_b64_tr_b16 %0,%1 offset:%c2":"=&v"(hi[ks]):"v"(vb),"i"(d0*4096+ks*1024+512):"memory");}
    asm volatile("s_waitcnt lgkmcnt(0)":::"memory");SBAR();
    #define PK(k) (bf16x8){lo[k][0],lo[k][1],lo[k][2],lo[k][3],hi[k][0],hi[k][1],hi[k][2],hi[k][3]}
    o[d0]=__builtin_amdgcn_mfma_f32_32x32x16_bf16(pa0,PK(0),o[d0],0,0,0);
    o[d0]=__builtin_amdgcn_mfma_f32_32x32x16_bf16(pa1,PK(1),o[d0],0,0,0);
    o[d0]=__builtin_amdgcn_mfma_f32_32x32x16_bf16(pa2,PK(2),o[d0],0,0,0);
    o[d0]=__builtin_amdgcn_mfma_f32_32x32x16_bf16(pa3,PK(3),o[d0],0,0,0);
    #undef PK
  }
}

#ifndef ATTN_STORE16
#define ATTN_STORE16(p,v) (*(u32x4*)(p)=(v))
#endif
template<int THRL> __device__ __forceinline__ void attn_unit(int qb,const bf16*Qh,const bf16*__restrict__ Kh,const bf16*__restrict__ Vh,bf16*Oh,char*shm,const int tid){
  const int lane=tid&63,r32=lane&31,hi=lane>>5; const int wid=__builtin_amdgcn_readfirstlane(tid>>6);
  const int q0=qb*QB;
  const bf16*Qw=Qh+(long)(q0+wid*QBLK)*DM;
  const unsigned lds0=(unsigned)(uintptr_t)shm;
  float*wsf=(float*)(shm+LDS_WS)+wid*64;
  const bf16*ksrc=Kh+(long)lane*DM+wid*8;
  const bf16*vsrc=Vh+(long)(16*(wid&3)+(lane>>2))*DM+(wid>>2)*32+(lane&3)*8;
  const unsigned kdst=lds0+LDS_K+wid*1024, vdst=lds0+LDS_V+wid*1024;
  #define DMA_K(t,slot) glds16(ksrc+(long)(t)*KVBLK*DM,(unsigned)__builtin_amdgcn_readfirstlane(kdst+(slot)))
  #define DMA_V(t,slot) glds16(vsrc+(long)(t)*KVBLK*DM,(unsigned)__builtin_amdgcn_readfirstlane(vdst+(slot)))
  const bf16*vsrc1=vsrc+64; const unsigned vdst1=lds0+LDS_V1+wid*1024;
  #define DMA_V1(t,slot) glds16(vsrc1+(long)(t)*KVBLK*DM,(unsigned)__builtin_amdgcn_readfirstlane(vdst1+(slot)))
  const int vb0=(int)(lds0+LDS_V)+((lane>>4)&1)*32+(lane&3)*8+(4*hi+((lane&15)>>2))*64;
  const int vb1=vb0+(LDS_V1-LDS_V);
  typedef __attribute__((address_space(3))) f32x4_t* o1ptr_t;
  const char*Kbase=shm+LDS_K; bf16x8 kf[8];
  const lds_cptr shm3=(lds_cptr)shm; const lds_cptr kp0=shm3+LDS_K+hi*1024+r32*16; const lds_cptr vp0=shm3+LDS_V+((lane>>4)&1)*32+(lane&3)*8+(4*hi+((lane&15)>>2))*64;
  const int NT=(q0+QB)/KVBLK;
  DMA_K(0,0);DMA_V(0,0);DMA_V1(0,0);DMA_K(1,SLOTB);
  bf16x8 qr[4];
  #pragma unroll
  for(int d0=0;d0<4;++d0)qr[d0]=*reinterpret_cast<const bf16x8*>(&Qw[(long)r32*DM+d0*16+hi*8]);
  typedef __attribute__((address_space(3))) bf16x8* qptr_t; const qptr_t qlds=(qptr_t)(shm3+LDS_QS+wid*4096)+lane;
  _Pragma("unroll") for(int d0=0;d0<4;++d0)qlds[d0*64]=qr[d0];
  #define QF(d) (qlds[(d)*64])
  float mhat=0.f,l_reg=0.f;f32x16 o[2];o[0]=f32x16{};o[1]=f32x16{};f32x16 o1_[2];o1_[0]=f32x16{};o1_[1]=f32x16{};
 float zf_=0.f;asm volatile("":"+v"(zf_));float nmv=zf_;
  #define NEGM(X) f32x16 X; _Pragma("unroll") for(int r_=0;r_<16;++r_)X[r_]=nmv; asm volatile("":"+v"(X))
  const int qrel=wid*QBLK+r32;
  #define CMASK(P0,P1,t) do{int jb_=(t)-(NT-4); if(jb_>=0)cmask(P0,P1,jb_,qrel,hi);}while(0)
  bool resc=false;
  #define START(P0,P1) do{ const float rm=rowmax(P0,P1); resc=false; \
    { const float dl=rm; mhat=fadd_s(mhat,dl); \
      _Pragma("unroll") for(int r=0;r<16;++r){P0[r]=fsub_s(P0[r],dl);P1[r]=fsub_s(P1[r],dl);} \
      nmv=-mhat; } \
    _Pragma("unroll") for(int r=0;r<16;++r)P0[r]=__builtin_amdgcn_exp2f(P0[r]); }while(0)
  #define RESC() do{ if(resc){ asm volatile("s_waitcnt lgkmcnt(0)":::"memory"); \
      _Pragma("unroll") for(int d_=0;d_<2;++d_) _Pragma("unroll") for(int r=0;r<16;++r){ const float f_=wsf[crow(r,hi)]; o[d_][r]*=f_; o1_[d_][r]*=f_; } } }while(0)
  f32x16 pA0,pA1,pB0,pB1;
  int sl_prev=0,sl_cur=0,sl_next=SLOTB;
  #define ROT() do{sl_prev=sl_cur;sl_cur=sl_next;sl_next=(sl_next==(NSLOT-1)*SLOTB)?0:sl_next+SLOTB;}while(0)
  DMA_K(2,2*SLOTB);
  WAIT_BAR(4);
  { NEGM(ng0_); qkt(pA0,pA1,Kbase,qr,ng0_,r32,hi); }asm volatile("s_nop 15\n\ts_nop 7":"+v"(pA0),"+v"(pA1));CMASK(pA0,pA1,0);
  START(pA0,pA1);
  _Pragma("unroll") for(int r=0;r<16;++r)pA1[r]=__builtin_amdgcn_exp2f(pA1[r]);
  WAIT_BAR(0);
  DMA_K(3,0);DMA_V(1,SLOTB);DMA_V1(1,SLOTB);
  ROT();
  kload8(kf,kp0+sl_cur);
  WAIT_BAR(3);
  s16x4 vlo[8],vhi[8]; u32x4 pw0,pw1,pw2,pw3;
  #define PKW(P,B) cvtpk_s(P[B],P[B+1])
  #define PAF(k) __builtin_bit_cast(bf16x8,pw##k)
  #define VFR(i) (bf16x8){vlo[i][0],vlo[i][1],vlo[i][2],vlo[i][3],vhi[i][0],vhi[i][1],vhi[i][2],vhi[i][3]}
  #define PIN(x) asm volatile("":"+v"(x))
  #define MX3(a,b,c) __builtin_fmaxf(__builtin_fmaxf((a),(b)),(c))
  #define GAPA(MF,A0,A1,A2,A3,W0,W1,PW) do{ MF; sacc+=A0; sacc+=A1; sacc+=A2; sacc+=A3; PIN(sacc); W0; W1; PIN(PW); SBAR(); }while(0)
  #define EX(v) __builtin_amdgcn_exp2f(v)
  #define GAPB(MF,X,B) do{ MF; X[B]=EX(X[B]); X[B+1]=EX(X[B+1]); X[B+2]=EX(X[B+2]); X[B+3]=EX(X[B+3]); PIN(X); SBAR(); }while(0)
  #define GAPB2(MF,X,B) do{ MF; X[B]=EX(X[B]); X[B+1]=EX(X[B+1]); PIN(X); SBAR(); }while(0)
  #define VRD(i) do{ vlo[i]=vtr(vp_+(((i)>>2)*4096+((i)&3)*1024)); vhi[i]=vtr(vp_+(((i)>>2)*4096+((i)&3)*1024+512)); }while(0)
  #define KRD(G,j) do{ if(G){ kload2(kf,kp0+sl_next,j); SBAR(); } }while(0)
  #define VRD1(i) do{ vlo[i]=vtr(vq_+(((i)>>2)*4096+((i)&3)*1024)); vhi[i]=vtr(vq_+(((i)>>2)*4096+((i)&3)*1024+512)); }while(0)
  #define STEP(C0,C1,P0,P1,t,GK,GV,GL) do{ SBAR(); \
    const lds_cptr vp_=vp0+sl_prev; \
    const bf16x8 qa_=QF(0), qb_=QF(1); NEGM(ng_); \
    VRD(0); SBAR(); float sacc=(P0[0]+P0[1]); \
    GAPA(C0=__builtin_amdgcn_mfma_f32_32x32x16_bf16(kf[0],qa_,ng_,0,0,0), P0[2],P0[3],P0[4],P0[5],     pw0[0]=PKW(P0,0), pw0[1]=PKW(P0,2), pw0); \
    VRD(4); SBAR(); GAPA(C1=__builtin_amdgcn_mfma_f32_32x32x16_bf16(kf[1],qa_,ng_,0,0,0), P0[6],P0[7],P0[8],P0[9],     pw0[2]=PKW(P0,4), pw0[3]=PKW(P0,6), pw0); \
    const bf16x8 qc_=QF(2); VRD(1); SBAR(); GAPA(C0=__builtin_amdgcn_mfma_f32_32x32x16_bf16(kf[2],qb_,C0,0,0,0),   P0[10],P0[11],P0[12],P0[13], pw1[0]=PKW(P0,8), pw1[1]=PKW(P0,10), pw1); \
    VRD(5); SBAR(); GAPA(C1=__builtin_amdgcn_mfma_f32_32x32x16_bf16(kf[3],qb_,C1,0,0,0),   P0[14],P0[15],P1[0],P1[1],   pw1[2]=PKW(P0,12),pw1[3]=PKW(P0,14), pw1); \
    const bf16x8 qd_=QF(3); VRD(2); SBAR(); GAPA(C0=__builtin_amdgcn_mfma_f32_32x32x16_bf16(kf[4],qc_,C0,0,0,0),   P1[2],P1[3],P1[4],P1[5],     pw2[0]=PKW(P1,0), pw2[1]=PKW(P1,2), pw2); \
    VRD(6); SBAR(); GAPA(C1=__builtin_amdgcn_mfma_f32_32x32x16_bf16(kf[5],qc_,C1,0,0,0),   P1[6],P1[7],P1[8],P1[9],     pw2[2]=PKW(P1,4), pw2[3]=PKW(P1,6), pw2); \
    VRD(3); SBAR(); GAPA(C0=__builtin_amdgcn_mfma_f32_32x32x16_bf16(kf[6],qd_,C0,0,0,0),   P1[10],P1[11],P1[12],P1[13], pw3[0]=PKW(P1,8), pw3[1]=PKW(P1,10), pw3); \
    VRD(7); SBAR(); GAPA(C1=__builtin_amdgcn_mfma_f32_32x32x16_bf16(kf[7],qd_,C1,0,0,0),   P1[14],P1[15],0.f,0.f,       pw3[2]=PKW(P1,12),pw3[3]=PKW(P1,14), pw3); \
    l_reg+=sacc; \
    if(GK){DMA_K((t)+3,sl_cur);} if(GV){DMA_V((t)+1,sl_next);DMA_V1((t)+1,sl_next);} \
    CMASK(C0,C1,t); \
    { float a=MX3(C0[0],C0[1],C1[0]),b=MX3(C0[2],C0[3],C1[1]); a=MX3(a,C1[2],C1[3]); \
      _Pragma("unroll") for(int r=4;r<16;r+=4){a=MX3(a,C0[r],C0[r+1]);b=MX3(b,C0[r+2],C0[r+3]);a=MX3(a,C1[r],C1[r+1]);b=MX3(b,C1[r+2],C1[r+3]);} \
      float rm=__builtin_fmaxf(a,b); { auto rr=__builtin_amdgcn_permlane32_swap(__float_as_uint(rm),__float_as_uint(rm),false,false); rm=__builtin_fmaxf(__uint_as_float(rr[0]),__uint_as_float(rr[1])); } \
      resc=false; \
      if(__builtin_expect(__any(rm>(float)THRL),0)){ const float dl=__builtin_fmaxf(rm,0.f); mhat+=dl; \
        _Pragma("unroll") for(int r=0;r<16;++r){C0[r]-=dl;C1[r]-=dl;} \
        nmv=-mhat; \
        const float f=__builtin_amdgcn_exp2f(-dl); l_reg*=f; if(hi==0)wsf[r32]=f; resc=true; } } \
    SBAR(); const lds_cptr vq_=vp0+(LDS_V1-LDS_V)+sl_prev; \
    GAPB2(o[0]=__builtin_amdgcn_mfma_f32_32x32x16_bf16(PAF(0),VFR(0),o[0],0,0,0), C0,0); VRD1(0); SBAR(); \
    GAPB2(o[1]=__builtin_amdgcn_mfma_f32_32x32x16_bf16(PAF(0),VFR(4),o[1],0,0,0), C0,2); VRD1(4); SBAR(); \
    KRD(GL,0); GAPB2(o[0]=__builtin_amdgcn_mfma_f32_32x32x16_bf16(PAF(1),VFR(1),o[0],0,0,0), C0,4); VRD1(1); SBAR(); \
    KRD(GL,1); GAPB2(o[1]=__builtin_amdgcn_mfma_f32_32x32x16_bf16(PAF(1),VFR(5),o[1],0,0,0), C0,6); VRD1(5); SBAR(); \
    KRD(GL,2); GAPB2(o[0]=__builtin_amdgcn_mfma_f32_32x32x16_bf16(PAF(2),VFR(2),o[0],0,0,0), C0,8); VRD1(2); SBAR(); \
    KRD(GL,3); GAPB2(o[1]=__builtin_amdgcn_mfma_f32_32x32x16_bf16(PAF(2),VFR(6),o[1],0,0,0), C0,10); VRD1(6); SBAR(); \
    GAPB2(o[0]=__builtin_amdgcn_mfma_f32_32x32x16_bf16(PAF(3),VFR(3),o[0],0,0,0), C0,12); VRD1(3); SBAR(); \
    GAPB2(o[1]=__builtin_amdgcn_mfma_f32_32x32x16_bf16(PAF(3),VFR(7),o[1],0,0,0), C0,14); VRD1(7); SBAR(); \
    GAPB2(o1_[0]=__builtin_amdgcn_mfma_f32_32x32x16_bf16(PAF(0),VFR(0),o1_[0],0,0,0), C1,0); \
    GAPB2(o1_[1]=__builtin_amdgcn_mfma_f32_32x32x16_bf16(PAF(0),VFR(4),o1_[1],0,0,0), C1,2); \
    GAPB2(o1_[0]=__builtin_amdgcn_mfma_f32_32x32x16_bf16(PAF(1),VFR(1),o1_[0],0,0,0), C1,4); \
    GAPB2(o1_[1]=__builtin_amdgcn_mfma_f32_32x32x16_bf16(PAF(1),VFR(5),o1_[1],0,0,0), C1,6); \
    GAPB2(o1_[0]=__builtin_amdgcn_mfma_f32_32x32x16_bf16(PAF(2),VFR(2),o1_[0],0,0,0), C1,8); \
    GAPB2(o1_[1]=__builtin_amdgcn_mfma_f32_32x32x16_bf16(PAF(2),VFR(6),o1_[1],0,0,0), C1,10); \
    GAPB2(o1_[0]=__builtin_amdgcn_mfma_f32_32x32x16_bf16(PAF(3),VFR(3),o1_[0],0,0,0), C1,12); \
    GAPB2(o1_[1]=__builtin_amdgcn_mfma_f32_32x32x16_bf16(PAF(3),VFR(7),o1_[1],0,0,0), C1,14); \
    }while(0)
  int t=1;
  #undef CMASK
  #define CMASK(P0,P1,t) do{}while(0)
  for(;t+5<NT;t+=2){
    STEP(pB0,pB1,pA0,pA1,t,true,true,true);     WAIT_BAR(3); RESC(); ROT();
    STEP(pA0,pA1,pB0,pB1,t+1,true,true,true);   WAIT_BAR(3); RESC(); ROT();
  }
  #undef CMASK
  #define CMASK(P0,P1,t) do{int jb_=(t)-(NT-4); if(jb_>=0)cmask(P0,P1,jb_,qrel,hi);}while(0)
  #define ENDW(tt) do{ if((tt)+3<NT){WAIT_BAR(3);} else if((tt)+2<NT){WAIT_BAR(2);} else {WAIT_BAR(0);} }while(0)
  for(;t+1<NT;t+=2){
    STEP(pB0,pB1,pA0,pA1,t,(t+3<NT),(t+1<NT),(t+1<NT));       ENDW(t);   RESC(); ROT();
    STEP(pA0,pA1,pB0,pB1,t+1,(t+4<NT),(t+2<NT),(t+2<NT));     ENDW(t+1); RESC(); ROT();
  }
  STEP(pB0,pB1,pA0,pA1,NT-1,false,false,false); RESC();
  { float sacc=pB0[0]+pB0[1]; _Pragma("unroll") for(int r=2;r<16;++r)sacc+=pB0[r]; _Pragma("unroll") for(int r=0;r<16;++r)sacc+=pB1[r]; l_reg+=sacc;
    pw0=(u32x4){PKW(pB0,0),PKW(pB0,2),PKW(pB0,4),PKW(pB0,6)};pw1=(u32x4){PKW(pB0,8),PKW(pB0,10),PKW(pB0,12),PKW(pB0,14)};pw2=(u32x4){PKW(pB1,0),PKW(pB1,2),PKW(pB1,4),PKW(pB1,6)};pw3=(u32x4){PKW(pB1,8),PKW(pB1,10),PKW(pB1,12),PKW(pB1,14)};
    SBAR(); pv(o,vb0+sl_cur,PAF(0),PAF(1),PAF(2),PAF(3)); }
  { SBAR(); pv(o1_,vb1+sl_cur,PAF(0),PAF(1),PAF(2),PAF(3)); }
  #undef PKW
  #undef PAF
  #undef VFR
  #undef PIN
  #undef MX3
  #undef GAPA
  #undef GAPB
  #undef EX
  #undef VRD
  #undef KRD
  #undef STEP
  #undef ENDW
  {auto rr=__builtin_amdgcn_permlane32_swap(__float_as_uint(l_reg),__float_as_uint(l_reg),false,false);l_reg=__uint_as_float(rr[0])+__uint_as_float(rr[1]);}
  if(hi==0)wsf[32+r32]=l_reg;asm volatile("s_waitcnt lgkmcnt(0)":::"memory");
  float rli[16];
  #pragma unroll
  for(int r=0;r<16;++r)rli[r]=__builtin_amdgcn_rcpf(wsf[32+crow(r,hi)]);
  bf16*Ow=Oh+(long)(q0+wid*QBLK)*DM;
  asm volatile("s_waitcnt lgkmcnt(0)\n\ts_barrier":::"memory");
  _Pragma("unroll") for(int hf=0;hf<2;++hf)
  { bf16*stg=(bf16*)(shm+LDS_OST)+wid*2048;
    #pragma unroll
    for(int r=0;r<16;++r){const int orow=crow(r,hi);
      #pragma unroll
      for(int d0=0;d0<2;++d0)stg[orow*64+d0*32+r32]=__float2bfloat16((hf?o1_[d0][r]:o[d0][r])*rli[r]);}
    asm volatile("s_waitcnt lgkmcnt(0)":::"memory");
    #pragma unroll
    for(int i=0;i<4;++i){const int row=i*8+(lane>>3),ch=lane&7; const u32x4 v=*(const u32x4*)(stg+row*64+ch*8); ATTN_STORE16(Ow+(long)row*DM+hf*64+ch*8,v);}
    asm volatile("s_waitcnt lgkmcnt(0)":::"memory"); }
  asm volatile("s_waitcnt lgkmcnt(0)\n\ts_barrier":::"memory");
  #undef DMA_K
  #undef DMA_V
  #undef DMA_V1
  #undef QF
  #undef NEGM
  #undef GAPB2
  #undef VRD1
  #undef CMASK
  #undef START
  #undef RESC
  #undef ROT
}
constexpr int ATTN_LDS_BYTES=LDS_BYTES;
#undef SBAR
#undef WAIT_BAR
}
#define LAS __attribute__((address_space(3)))
#define GAS __attribute__((address_space(1)))
typedef unsigned short bf16;
typedef unsigned v4u __attribute__((ext_vector_type(4)));
typedef unsigned v2u __attribute__((ext_vector_type(2)));
typedef float f32x4 __attribute__((ext_vector_type(4)));
#ifndef MK_SINGLE
#define MK_SINGLE 1
#endif
constexpr int NWAVES = 8;
constexpr int L = 16400, LP = 16640, TP = 16512, NCH = 129, CHT = 128, NMETA = 16, NPH = 45;
constexpr size_t MiB = 1u << 20, HMiB = 1u << 19;
constexpr size_t WS_HM = HMiB, WS_WIN = 1 * MiB, WS_WOUT = 7 * MiB, WS_W1 = 9 * MiB, WS_W2 = 17 * MiB, WS_WLR = 25 * MiB, WS_WPOOL = 26 * MiB;
constexpr size_t WS_XN = 27 * MiB, WS_PRQ = 27 * MiB, WS_DP = 27 * MiB, WS_Z = 43 * MiB + HMiB;
constexpr size_t WS_Y = 59 * MiB + HMiB, WS_LR = WS_Y, WS_PP = WS_Y, WS_M1E = WS_Y, WS_F = WS_Y, WS_OZO = WS_Y;
constexpr size_t WS_OZE = 108 * MiB + HMiB, WS_BON = 141 * MiB, WS_REC = 143 * MiB;
constexpr size_t WS_GPP = 92 * MiB;
constexpr size_t WS_Q = 92 * MiB, WS_K = 124 * MiB + HMiB, WS_V = 157 * MiB, WS_O0 = 189 * MiB + HMiB, WS_O1 = 222 * MiB, WS_M1O = 92 * MiB, WS_HID = 92 * MiB;
constexpr size_t WS_END = 256 * MiB;
constexpr size_t ACT_BYTES = (size_t)LP * 1024 * 2;
static_assert(WS_PRQ + (size_t)TP * 8 * 128 * 2 <= WS_Y && WS_REC + (size_t)TP * 8 * 448 * 2 <= WS_END && WS_O1 + ACT_BYTES <= WS_END && WS_HID + 4 * ACT_BYTES <= WS_END, "ws map");
static_assert(WS_Y + (size_t)LP * 2304 * 2 <= WS_REC && WS_LR + (size_t)LP * 1536 * 2 <= WS_OZE && WS_OZE + ACT_BYTES <= WS_BON && WS_K - WS_Q == ACT_BYTES && WS_V - WS_K == ACT_BYTES, "ws map 2");
constexpr int LDS_BYTES = 147456;
constexpr float C2Q = 0.125f * 1.4426950408889634f;

__device__ __forceinline__ unsigned f2bf(float f) { unsigned u = __builtin_bit_cast(unsigned, f); return (u + 0x7fffu + ((u >> 16) & 1u)) >> 16; }
__device__ __forceinline__ unsigned pk2(float lo, float hi) { return f2bf(lo) | (f2bf(hi) << 16); }
__device__ __forceinline__ float bf2f(bf16 b) { return __builtin_bit_cast(float, (unsigned)b << 16); }
__device__ __forceinline__ float bflo(unsigned w) { return __builtin_bit_cast(float, w << 16); }
__device__ __forceinline__ float bfhi(unsigned w) { return __builtin_bit_cast(float, w & 0xffff0000u); }
__device__ __forceinline__ float wave_sum(float v) {
#pragma unroll
    for (int o = 1; o < 64; o <<= 1) v += __shfl_xor(v, o);
    return v;
}
struct Args { const float* in[24]; float* out; unsigned char* ws; int ph_lo, ph_hi; };
__device__ __forceinline__ const float* inp_ptr(const Args& a, int i) { asm volatile("" : "+s"(i)); return a.in[i]; }

__device__ __forceinline__ void transpose_item(const float* W, int K, int N, bf16* WT, LAS float* scr, int item, int lane, int perm_rows = 0) {
    const int nblk = N / 32, kb = item / nblk, nb = item % nblk, k0 = 64 * kb, n0 = 32 * nb;
#pragma unroll 8
    for (int i = 0; i < 32; ++i) { const int kk = 2 * i + (lane >> 5); scr[kk * 33 + (lane & 31)] = W[(size_t)(k0 + kk) * N + n0 + (lane & 31)]; }
    asm volatile("s_waitcnt lgkmcnt(0)" ::: "memory");
    const int c = lane & 7;
#pragma unroll
    for (int j = 0; j < 4; ++j) { const int n = (lane >> 3) + 8 * j; const LAS float* s = scr + (8 * c) * 33 + n;
        v4u o; o.x = pk2(s[0 * 33], s[1 * 33]); o.y = pk2(s[2 * 33], s[3 * 33]); o.z = pk2(s[4 * 33], s[5 * 33]); o.w = pk2(s[6 * 33], s[7 * 33]);
        int nr = n0 + n; if (nr < perm_rows) { const int d = nr & 63; nr = (nr & ~63) + ((d < 32) ? 2 * d : 2 * (d - 32) + 1); }
        *(v4u*)(WT + (size_t)nr * K + k0 + 8 * c) = o; }
    asm volatile("s_waitcnt lgkmcnt(0)" ::: "memory");
}
__device__ __forceinline__ void wconv(const Args& a, int layer, LAS float* scr, int gw, int NGW, int lane, int gtid, int NTHR) {
    const int j = layer >> 1; const bool odd = layer & 1; unsigned char* ws = a.ws;
    const float* Win = odd ? inp_ptr(a, 20) + (size_t)j * 1024 * 3072 : inp_ptr(a, 5) + (size_t)j * 1024 * 2304; const int Nin = odd ? 3072 : 2304;
    const float* Wout = (odd ? inp_ptr(a, 23) : inp_ptr(a, 19)) + (size_t)j * 1024 * 1024;
    const float* W1 = inp_ptr(a, 3) + (size_t)layer * 1024 * 4096; const float* W2 = inp_ptr(a, 4) + (size_t)layer * 4096 * 1024;
    const int I_in = 16 * (Nin / 32), I_out = 16 * 32, I_1 = 16 * 128, I_2 = 64 * 32;
    const int it_hi = odd ? I_in + I_out + I_1 + I_2 : I_in + I_out;
    for (int it = gw; it < it_hi; it += NGW) {
        int r = it;
        if (r < I_in) { transpose_item(Win, 1024, Nin, (bf16*)(ws + WS_WIN), scr, r, lane, odd ? 2048 : 0); continue; } r -= I_in;
        if (r < I_out) { transpose_item(Wout, 1024, 1024, (bf16*)(ws + WS_WOUT), scr, r, lane); continue; } r -= I_out;
        if (r < I_1) { transpose_item(W1, 1024, 4096, (bf16*)(ws + WS_W1), scr, r, lane); continue; } r -= I_1;
        transpose_item(W2, 4096, 1024, (bf16*)(ws + WS_W2), scr, r, lane);
    }
    if (!odd) {
        const float* w_up = inp_ptr(a, 8) + (size_t)j * 64 * 512; const float* a_up = inp_ptr(a, 10) + (size_t)j * 64 * 512; const float* g_up = inp_ptr(a, 11) + (size_t)j * 128 * 512;
        const float* pw = inp_ptr(a, 17) + (size_t)j * 4 * 128 * 128;
        bf16* WLR = (bf16*)(ws + WS_WLR); bf16* WPL = (bf16*)(ws + WS_WPOOL);
        for (int idx = gtid; idx < 1536 * 256; idx += NTHR) { const int n = idx >> 8, k = idx & 255; float v = 0.f;
            if (n < 512) { if (k < 64) v = w_up[k * 512 + n]; }
            else if (n < 1024) { if (k >= 64 && k < 128) v = a_up[(k - 64) * 512 + (n - 512)]; }
            else { if (k >= 128) v = g_up[(k - 128) * 512 + (n - 1024)]; }
            WLR[idx] = (bf16)f2bf(v); }
        for (int idx = gtid; idx < 512 * 512; idx += NTHR) { const int n = idx >> 9, k = idx & 511; const int g = n >> 7; float v = 0.f;
            if ((k >> 7) == g) v = pw[((size_t)g * 128 + (k & 127)) * 128 + (n & 127)];
            WPL[idx] = (bf16)f2bf(v); }
    }
}
__device__ __forceinline__ void wconv_mlp(const Args& a, int layer, int part, LAS float* scr, int widx, int nwork, int lane) {
    unsigned char* ws = a.ws;
    if (part == 0) { const float* W1 = inp_ptr(a, 3) + (size_t)layer * 1024 * 4096;
        for (int it = widx; it < 16 * 128; it += nwork) transpose_item(W1, 1024, 4096, (bf16*)(ws + WS_W1), scr, it, lane); }
    else { const float* W2 = inp_ptr(a, 4) + (size_t)layer * 4096 * 1024;
        for (int it = (part - 1) * 1024 + widx; it < part * 1024; it += nwork) transpose_item(W2, 4096, 1024, (bf16*)(ws + WS_W2), scr, it, lane); }
}
typedef short bf16x8_t __attribute__((ext_vector_type(8)));
__device__ __forceinline__ void thin_gemm(const bf16* A, const bf16* Bt, int N, int K, bf16* O, int ldc, const float* cscale, int split_cols, size_t split_stride, int act, int rope, LAS float* red, int vcu, int G, int tid, int wave, int lane) {
    const int ntile = N >> 4, ks = K >> 3, lr = lane & 15, lq = lane >> 4;
    for (int tile = vcu; tile < ntile; tile += G) {
        const bf16* ap = A + (size_t)lr * K + wave * ks + 8 * lq; const bf16* bp = Bt + (size_t)(tile * 16 + lr) * K + wave * ks + 8 * lq;
        f32x4 acc = {0.f, 0.f, 0.f, 0.f};
        for (int k = 0; k < ks; k += 32) { const bf16x8_t av = *(const bf16x8_t*)(ap + k), bv = *(const bf16x8_t*)(bp + k); acc = __builtin_amdgcn_mfma_f32_16x16x32_bf16(av, bv, acc, 0, 0, 0); }
#pragma unroll
        for (int r = 0; r < 4; ++r) red[wave * 256 + (4 * lq + r) * 16 + lr] = acc[r];
        __syncthreads();
        if (tid < 256) { float s = 0.f;
#pragma unroll
            for (int w = 0; w < 8; ++w) s += red[w * 256 + tid];
            const int m = tid >> 4; int col = tile * 16 + (tid & 15);
            if (act == 1) { s = fmaxf(s, 0.f); s = s * s; }
            if (cscale) s *= cscale[col];
            bf16* base = O; int tsel = 0; if (split_cols) { const int tt = col / split_cols; base += (size_t)tt * split_stride; col -= tt * split_cols; tsel = tt; }
            { const float other = __shfl_xor(s, 1);
              if (rope && tsel < 2) { const int jj = (col & 63) >> 1; const float inv = expf(-(float)jj * (9.210340371976184f / 32.f)); const float ang = (float)m * inv; const double rev = (double)ang * 0.15915494309189535; const float fr_ = (float)(rev - __builtin_rint(rev));
                  const float qs = tsel == 0 ? 0.18033688011112042f : 1.f; const float cs = __builtin_amdgcn_cosf(fr_) * qs, sn = __builtin_amdgcn_sinf(fr_) * qs;
                  s = (col & 1) ? (s * cs + other * sn) : (s * cs - other * sn); } }
            base[(size_t)m * ldc + col] = (bf16)f2bf(s); }
        __syncthreads();
    }
}
__device__ __forceinline__ void norm_rows(int mode, const float* xin, const float* meta, float* out, float* hm, const bf16* Msrc, const float* ga, const float* gb, bf16* XN, int gw, int NGW, int lane) {
    for (int t = gw; t < L; t += NGW) {
        v2u* xo = (v2u*)(XN + (size_t)t * 1024) + lane;
        if (mode == 2 && t < NMETA) continue;
        float* hrow = t < NMETA ? hm + (size_t)t * 1024 : out + (size_t)(t - NMETA) * 1024;
        f32x4 v[4];
        const float* hsrc = (mode == 0 || mode == 3) ? (t < NMETA ? meta + (size_t)t * 1024 : xin + (size_t)(t - NMETA) * 1024) : hrow;
        if (mode == 0) {
#pragma unroll
            for (int j = 0; j < 4; ++j) v[j] = ((const f32x4*)hsrc)[lane + 64 * j]; }
        else { const v2u* mp = (const v2u*)(Msrc + (size_t)t * 1024) + lane; f32x4 m[4]; float ss = 0.f;
#pragma unroll
            for (int j = 0; j < 4; ++j) { const v2u w = mp[64 * j]; m[j] = (f32x4){bflo(w.x), bfhi(w.x), bflo(w.y), bfhi(w.y)}; ss += (m[j].x * m[j].x + m[j].y * m[j].y) + (m[j].z * m[j].z + m[j].w * m[j].w); }
            const float rs = 1.0f / sqrtf(wave_sum(ss) * (1.f / 1024.f) + 1e-6f);
#pragma unroll
            for (int j = 0; j < 4; ++j) { const f32x4 g = ((const f32x4*)ga)[lane + 64 * j]; const f32x4 hv = ((const f32x4*)hsrc)[lane + 64 * j]; v[j] = hv + m[j] * rs * g; ((f32x4*)hrow)[lane + 64 * j] = v[j]; } }
        if (mode != 2) { float s2 = 0.f;
#pragma unroll
            for (int j = 0; j < 4; ++j) s2 += (v[j].x * v[j].x + v[j].y * v[j].y) + (v[j].z * v[j].z + v[j].w * v[j].w);
            const float r2 = 1.0f / sqrtf(wave_sum(s2) * (1.f / 1024.f) + 1e-6f);
#pragma unroll
            for (int j = 0; j < 4; ++j) { const f32x4 g = ((const f32x4*)gb)[lane + 64 * j]; const f32x4 o = v[j] * r2 * g; xo[64 * j] = (v2u){pk2(o.x, o.y), pk2(o.z, o.w)}; } }
    }
}
__device__ __forceinline__ void unpack8(const v4u w, float (&f)[8]) { f[0] = bflo(w.x); f[1] = bfhi(w.x); f[2] = bflo(w.y); f[3] = bfhi(w.y); f[4] = bflo(w.z); f[5] = bfhi(w.z); f[6] = bflo(w.w); f[7] = bfhi(w.w); }
__device__ __forceinline__ v4u pack8(const float (&f)[8]) { v4u o; o.x = pk2(f[0], f[1]); o.y = pk2(f[2], f[3]); o.z = pk2(f[4], f[5]); o.w = pk2(f[6], f[7]); return o; }
__device__ __forceinline__ void shift_rows(const bf16* Y, const float* mu, bf16* REC, bf16* Z, bf16* DP, int gw, int NGW, int lane) {
    for (int t = gw; t < L; t += NGW) {
        const bf16* y = Y + (size_t)t * 2304; const bool hp = t > 0;
        v4u cur[4], prv[4];
#pragma unroll
        for (int q = 0; q < 4; ++q) { const int ci = q * 64 + lane; const bool ok = ci < 224;
            cur[q] = ok ? *(const v4u*)(y + 8 * ci) : (v4u){0u, 0u, 0u, 0u}; prv[q] = (ok && hp) ? *(const v4u*)(y - 2304 + 8 * ci) : (v4u){0u, 0u, 0u, 0u}; }
        float ps[8] = {0.f, 0.f, 0.f, 0.f, 0.f, 0.f, 0.f, 0.f}, pc[8];
        { const int win = 2 << (lane >> 4); const int n = (t + 1) < win ? (t + 1) : win; const bf16* yp = y + 1792 + 8 * lane;
          { float f[8]; unpack8(*(const v4u*)yp, f);
#pragma unroll
            for (int e = 0; e < 8; ++e) { pc[e] = f[e]; ps[e] = f[e]; } }
          for (int s = 1; s < n; ++s) { float f[8]; unpack8(*(const v4u*)(yp - (ptrdiff_t)s * 2304), f);
#pragma unroll
            for (int e = 0; e < 8; ++e) ps[e] += f[e]; }
          const float rn = 1.f / (float)n; float o[8];
#pragma unroll
          for (int e = 0; e < 8; ++e) o[e] = ps[e] * rn - pc[e];
          *(v4u*)(DP + (size_t)t * 512 + 8 * lane) = pack8(o); }
#pragma unroll
        for (int q = 0; q < 4; ++q) { const int ci = q * 64 + lane; if (ci < 224) {
            const int c0 = 8 * ci; float a[8], b[8], o[8]; unpack8(cur[q], a); unpack8(prv[q], b);
            const f32x4 m0 = *(const f32x4*)(mu + c0), m1 = *(const f32x4*)(mu + c0 + 4); const float mm[8] = {m0.x, m0.y, m0.z, m0.w, m1.x, m1.y, m1.z, m1.w};
#pragma unroll
            for (int e = 0; e < 8; ++e) o[e] = a[e] + (b[e] - a[e]) * mm[e];
            if (c0 < 1536) { if (t < TP) { const int vec = c0 >> 9, hh = (c0 & 511) >> 6, i0 = c0 & 63; const int slot = vec == 0 ? 0 : (vec == 1 ? 2 : 3);
                    *(v4u*)(REC + (((size_t)hh * TP + t) * 7 + slot) * 64 + i0) = pack8(o); } }
            else { const int zc = c0 - 1536;
                if (zc < 64) {
#pragma unroll
                    for (int e = 0; e < 8; ++e) o[e] = tanhf(o[e]); }
                else if (zc >= 128) {
#pragma unroll
                    for (int e = 0; e < 8; ++e) o[e] = 1.f / (1.f + __expf(-o[e])); }
                *(v4u*)(Z + (size_t)t * 256 + zc) = pack8(o); } } }
    }
}
__device__ __forceinline__ void prep_rows(const bf16* LR, bf16* REC, float* BON, const float* w0, const float* a0, const float* k_k, const float* k_a, const float* r_k, int gw, int NGW, int lane) {
    const int hh = lane >> 3, i0 = (lane & 7) * 8, c0 = hh * 64 + i0;
    float pw0[8], pa0[8], pkk[8], pka[8], prk[8];
#pragma unroll
    for (int e = 0; e < 8; ++e) { pw0[e] = w0[c0 + e]; pa0[e] = a0[c0 + e]; pkk[e] = k_k[c0 + e]; pka[e] = k_a[c0 + e]; prk[e] = r_k[c0 + e]; }
    for (int t = gw; t < L; t += NGW) {
        bf16* rec = REC + ((size_t)hh * TP + t) * 448 + i0; const bf16* lr = LR + (size_t)t * 1536 + c0;
        float r[8], kr[8], lw[8], la[8], lg[8];
        unpack8(*(const v4u*)rec, r); unpack8(*(const v4u*)(rec + 128), kr); unpack8(*(const v4u*)lr, lw); unpack8(*(const v4u*)(lr + 512), la); unpack8(*(const v4u*)(lr + 1024), lg);
        float ev[8], kv[8], kk[8], bb[8]; float nsq = 0.f, bon = 0.f;
#pragma unroll
        for (int e = 0; e < 8; ++e) {
            const float nx = -(pw0[e] + lw[e]); const float sp = fmaxf(nx, 0.f) + log1pf(__expf(-fabsf(nx)));
            ev[e] = __expf(-sp - 0.5f);
            const float av = 1.f / (1.f + __expf(-(pa0[e] + la[e])));
            kk[e] = kr[e] * pkk[e]; nsq += kk[e] * kk[e];
            kv[e] = kr[e] * (1.f + (av - 1.f) * pka[e]); bon += r[e] * kv[e] * prk[e]; bb[e] = av; }
        nsq += __shfl_xor(nsq, 1); nsq += __shfl_xor(nsq, 2); nsq += __shfl_xor(nsq, 4);
        bon += __shfl_xor(bon, 1); bon += __shfl_xor(bon, 2); bon += __shfl_xor(bon, 4);
        const float rn = 1.f / fmaxf(sqrtf(nsq), 1e-12f);
#pragma unroll
        for (int e = 0; e < 8; ++e) { kk[e] *= rn; bb[e] *= kk[e]; }
        *(v4u*)(rec + 64) = pack8(ev); *(v4u*)(rec + 128) = pack8(kv); *(v4u*)(rec + 256) = pack8(kk); *(v4u*)(rec + 320) = pack8(bb); *(v4u*)(rec + 384) = pack8(lg);
        if ((lane & 7) == 0) BON[hh * TP + t] = bon;
    }
}
__device__ __forceinline__ void scan_stage(const bf16* rec_h, int t0, LAS float* wl, int lane) {
    const v4u* src = (const v4u*)(rec_h + (size_t)t0 * 448);
#pragma unroll
    for (int q = 0; q < 7; ++q) {
        const int ci = q * 64 + lane; const v4u raw = src[ci]; const bool isw = ((ci % 56) >> 3) == 1;
        float f[8] = {bflo(raw.x), bfhi(raw.x), bflo(raw.y), bfhi(raw.y), bflo(raw.z), bfhi(raw.z), bflo(raw.w), bfhi(raw.w)};
        if (isw) {
#pragma unroll
            for (int e = 0; e < 8; ++e) f[e] = __expf(-f[e]); }
        LAS f32x4* dst = (LAS f32x4*)(wl + ci * 8);
        dst[0] = (f32x4){f[0], f[1], f[2], f[3]}; dst[1] = (f32x4){f[4], f[5], f[6], f[7]};
    }
}
__device__ __forceinline__ float half_sum(float x) { return x + __shfl_xor(x, 32); }
__device__ __forceinline__ void scan1(const bf16* REC, float* PP, bf16* PRQ, LAS float* wl, int gw, int NGW, int lane) {
    for (int task = gw; task < NCH * 16; task += NGW) {
        asm volatile("" : "+v"(lane));
        const int c = task >> 4, hh = (task >> 1) & 7, rh = task & 1, kh = lane >> 5, row = 32 * rh + (lane & 31); const bf16* rec_h = REC + (size_t)hh * TP * 448;
        float P[32], Q[32];
#pragma unroll
        for (int k = 0; k < 32; ++k) { P[k] = (32 * kh + k == row) ? 1.f : 0.f; Q[k] = 0.f; }
        const int tend = (c + 1) * CHT < L ? (c + 1) * CHT : L;
        for (int t0 = c * CHT; t0 < tend; t0 += 8) {
            scan_stage(rec_h, t0, wl, lane);
#pragma unroll 1
            for (int s = 0; s < 8; ++s) {
                const LAS float* b = wl + s * 448 + 32 * kh; const float vv = wl[s * 448 + 192 + row];
                f32x4 kk8[8], w8[8], b8[8], k8[8];
#pragma unroll
                for (int q = 0; q < 8; ++q) kk8[q] = *(const LAS f32x4*)(b + 256 + 4 * q);
#pragma unroll
                for (int q = 0; q < 8; ++q) { w8[q] = *(const LAS f32x4*)(b + 64 + 4 * q); b8[q] = *(const LAS f32x4*)(b + 320 + 4 * q); k8[q] = *(const LAS f32x4*)(b + 128 + 4 * q); }
                float sp0 = 0.f, sp1 = 0.f, sq0 = 0.f, sq1 = 0.f;
#pragma unroll
                for (int q = 0; q < 8; ++q) { sp0 += P[4 * q] * kk8[q].x; sp1 += P[4 * q + 1] * kk8[q].y; sp0 += P[4 * q + 2] * kk8[q].z; sp1 += P[4 * q + 3] * kk8[q].w;
                    sq0 += Q[4 * q] * kk8[q].x; sq1 += Q[4 * q + 1] * kk8[q].y; sq0 += Q[4 * q + 2] * kk8[q].z; sq1 += Q[4 * q + 3] * kk8[q].w; }
                const float sap = -half_sum(sp0 + sp1), saq = -half_sum(sq0 + sq1);
                f32x4 r8[8];
#pragma unroll
                for (int q = 0; q < 8; ++q) r8[q] = *(const LAS f32x4*)(b + 4 * q);
#pragma unroll
                for (int q = 0; q < 8; ++q)
#pragma unroll
                    for (int e = 0; e < 4; ++e) { P[4 * q + e] = P[4 * q + e] * w8[q][e] + sap * b8[q][e]; Q[4 * q + e] = Q[4 * q + e] * w8[q][e] + (saq * b8[q][e] + vv * k8[q][e]); }
                float pr0 = 0.f, pr1 = 0.f, qr0 = 0.f, qr1 = 0.f;
#pragma unroll
                for (int q = 0; q < 8; ++q) { pr0 += P[4 * q] * r8[q].x; pr1 += P[4 * q + 1] * r8[q].y; pr0 += P[4 * q + 2] * r8[q].z; pr1 += P[4 * q + 3] * r8[q].w;
                    qr0 += Q[4 * q] * r8[q].x; qr1 += Q[4 * q + 1] * r8[q].y; qr0 += Q[4 * q + 2] * r8[q].z; qr1 += Q[4 * q + 3] * r8[q].w; }
                const float prs = half_sum(pr0 + pr1), qrs = half_sum(qr0 + qr1);
                bf16* pq = PRQ + ((size_t)hh * TP + t0 + s) * 128 + row; pq[kh * 64] = (bf16)f2bf(kh ? qrs : prs);
            }
        }
        f32x4* po = (f32x4*)(PP + ((size_t)(c * 8 + hh) * 2) * 4096 + (size_t)row * 64 + 32 * kh); f32x4* qo = po + 1024;
#pragma unroll
        for (int q = 0; q < 8; ++q) { po[q] = (f32x4){P[4 * q], P[4 * q + 1], P[4 * q + 2], P[4 * q + 3]}; qo[q] = (f32x4){Q[4 * q], Q[4 * q + 1], Q[4 * q + 2], Q[4 * q + 3]}; }
    }
}
template <int NRT> __device__ __forceinline__ void chain(const float* phi, size_t mstride, int nsteps, const float* init_src, float* out_each, size_t out_stride, float* fin, LAS float* sb, int tid, int wave, int lane) {
    constexpr int ROWS = NRT == 4 ? 128 : 64;
    const int lr = lane & 15, lq = lane >> 4, jb = wave >> 1, i0 = (wave & 1) * NRT; const bool qpart = (NRT == 2) || (wave & 1);
    for (int u = tid; u < ROWS * 68; u += 512) { const int r = u / 68, cidx = u - r * 68; float v = 0.f;
        if (NRT == 4) v = (r < 64 && cidx == r) ? 1.f : 0.f; else if (init_src && cidx < 64) v = init_src[r * 64 + cidx];
        sb[u] = v; }
    __syncthreads();
    f32x4 bfr[4], acc[NRT];
    { const f32x4* bp = (const f32x4*)(phi + (16 * jb + lr) * 0 + 0); (void)bp; }
#pragma unroll
    for (int q = 0; q < 4; ++q) { f32x4 t4;
#pragma unroll
        for (int e = 0; e < 4; ++e) t4[e] = phi[(16 * lq + 4 * q + e) * 64 + 16 * jb + lr]; bfr[q] = t4; }
#pragma unroll
    for (int ii = 0; ii < NRT; ++ii)
#pragma unroll
        for (int r = 0; r < 4; ++r) acc[ii][r] = qpart ? phi[4096 + (16 * ((i0 + ii) & 3) + 4 * lq + r) * 64 + 16 * jb + lr] : 0.f;
    int cur = 0;
    for (int s = 0; s < nsteps; ++s) {
        f32x4 nb[4], nacc[NRT]; const bool more = (s + 1) < nsteps; const float* np = phi + (size_t)(more ? s + 1 : s) * mstride;
#pragma unroll
        for (int q = 0; q < 4; ++q) { f32x4 t4;
#pragma unroll
            for (int e = 0; e < 4; ++e) t4[e] = np[(16 * lq + 4 * q + e) * 64 + 16 * jb + lr]; nb[q] = t4; }
#pragma unroll
        for (int ii = 0; ii < NRT; ++ii)
#pragma unroll
            for (int r = 0; r < 4; ++r) nacc[ii][r] = (more && qpart) ? np[4096 + (16 * ((i0 + ii) & 3) + 4 * lq + r) * 64 + 16 * jb + lr] : 0.f;
        const LAS float* S = sb + cur * ROWS * 68;
#pragma unroll
        for (int ii = 0; ii < NRT; ++ii) { const LAS f32x4* ap = (const LAS f32x4*)(S + (16 * (i0 + ii) + lr) * 68 + 16 * lq);
#pragma unroll
            for (int q = 0; q < 4; ++q) { const f32x4 a4 = ap[q];
#pragma unroll
                for (int e = 0; e < 4; ++e) acc[ii] = __builtin_amdgcn_mfma_f32_16x16x4f32(a4[e], bfr[q][e], acc[ii], 0, 0, 0); } }
        LAS float* Sn = sb + (cur ^ 1) * ROWS * 68;
#pragma unroll
        for (int ii = 0; ii < NRT; ++ii)
#pragma unroll
            for (int r = 0; r < 4; ++r) { const int row = 16 * (i0 + ii) + 4 * lq + r, col = 16 * jb + lr; Sn[row * 68 + col] = acc[ii][r];
                if (NRT == 2) out_each[(size_t)s * out_stride + row * 64 + col] = acc[ii][r];
                else if (!more) fin[row * 64 + col] = acc[ii][r]; }
        __syncthreads(); cur ^= 1;
#pragma unroll
        for (int q = 0; q < 4; ++q) bfr[q] = nb[q];
#pragma unroll
        for (int ii = 0; ii < NRT; ++ii) acc[ii] = nacc[ii];
    }
}
__device__ __forceinline__ void scan_out(const bf16* REC, const float* PP, const bf16* PRQ, const float* BON, const float* ln_w, const float* ln_b, bf16* OZ, int vcu, int G, int wave, int lane) {
    const int lr = lane & 15, lq = lane >> 4;
    for (int task = vcu; task < NCH * 8; task += G) {
        const int c = task >> 3, hh = task & 7, t0 = c * CHT + 16 * wave;
        f32x4 acc[4];
#pragma unroll
        for (int nt = 0; nt < 4; ++nt)
#pragma unroll
            for (int r = 0; r < 4; ++r) acc[nt][r] = bf2f(PRQ[((size_t)hh * TP + t0 + 4 * lq + r) * 128 + 64 + 16 * nt + lr]);
        if (c > 0) { const float* S0 = PP + ((size_t)((c - 1) * 8 + hh) * 2 + 1) * 4096; const bf16* pr = PRQ + ((size_t)hh * TP + t0 + lr) * 128 + 16 * lq;
            float av[16]; { float f0[8], f1[8]; unpack8(*(const v4u*)pr, f0); unpack8(*(const v4u*)(pr + 8), f1);
#pragma unroll
                for (int e = 0; e < 8; ++e) { av[e] = f0[e]; av[8 + e] = f1[e]; } }
#pragma unroll
            for (int nt = 0; nt < 4; ++nt) { const f32x4* sp = (const f32x4*)(S0 + (16 * nt + lr) * 64 + 16 * lq); const f32x4 b0 = sp[0], b1 = sp[1], b2 = sp[2], b3 = sp[3];
                const float bv[16] = {b0.x, b0.y, b0.z, b0.w, b1.x, b1.y, b1.z, b1.w, b2.x, b2.y, b2.z, b2.w, b3.x, b3.y, b3.z, b3.w};
#pragma unroll
                for (int kk = 0; kk < 16; ++kk) acc[nt] = __builtin_amdgcn_mfma_f32_16x16x4f32(av[kk], bv[kk], acc[nt], 0, 0, 0); } }
#pragma unroll
        for (int r = 0; r < 4; ++r) { const int t = t0 + 4 * lq + r;
            float s = (acc[0][r] + acc[1][r]) + (acc[2][r] + acc[3][r]); s += __shfl_xor(s, 1); s += __shfl_xor(s, 2); s += __shfl_xor(s, 4); s += __shfl_xor(s, 8);
            const float mean = s * (1.f / 64.f); float d[4], q = 0.f;
#pragma unroll
            for (int nt = 0; nt < 4; ++nt) { d[nt] = acc[nt][r] - mean; q += d[nt] * d[nt]; }
            q += __shfl_xor(q, 1); q += __shfl_xor(q, 2); q += __shfl_xor(q, 4); q += __shfl_xor(q, 8);
            const float rs = 1.0f / sqrtf(q * (1.f / 64.f) + 64e-5f);
            if (t < L) { const float bon = BON[hh * TP + t]; const bf16* rec = REC + ((size_t)hh * TP + t) * 448;
#pragma unroll
                for (int nt = 0; nt < 4; ++nt) { const int v = 16 * nt + lr, cc = hh * 64 + v;
                    const float y = d[nt] * rs * ln_w[cc] + ln_b[cc];
                    OZ[(size_t)t * 1024 + cc] = (bf16)f2bf((y + bon * bf2f(rec[192 + v])) * bf2f(rec[384 + v])); } }
        }
    }
}
__device__ __forceinline__ void zero_pad_rows(bf16* Qb, bf16* Kb, bf16* Vb, int gtid, int NTHR) {
    const v4u z = {0u, 0u, 0u, 0u};
    for (int idx = gtid; idx < (LP - L) * 128; idx += NTHR) { const size_t off = (size_t)L * 1024 + (size_t)idx * 8; *(v4u*)(Qb + off) = z; *(v4u*)(Kb + off) = z; *(v4u*)(Vb + off) = z; }
}
__device__ __forceinline__ void combine_rows(const bf16* O0, const bf16* O1, const float* lamv, const float* subw, float lam_init, bf16* OZ, int gw, int NGW, int lane) {
    const float d01 = wave_sum(lamv[lane] * lamv[64 + lane]), d23 = wave_sum(lamv[128 + lane] * lamv[192 + lane]);
    const float lam = __expf(d01) - __expf(d23) + lam_init; const float post = 1.f - lam_init;
    float sw[16];
#pragma unroll
    for (int k = 0; k < 16; ++k) sw[k] = subw[((lane & 7) * 16) + k] * post;
    for (int t = gw; t < L; t += NGW) {
        const v4u* p0 = (const v4u*)(O0 + (size_t)t * 1024 + lane * 16); const v4u* p1 = (const v4u*)(O1 + (size_t)t * 1024 + lane * 16);
        float o[16]; float ss = 0.f;
#pragma unroll
        for (int h2 = 0; h2 < 2; ++h2) { const v4u a = p0[h2], b = p1[h2];
            const unsigned aw[4] = {a.x, a.y, a.z, a.w}, bw[4] = {b.x, b.y, b.z, b.w};
#pragma unroll
            for (int e = 0; e < 4; ++e) { o[h2 * 8 + 2 * e] = bflo(aw[e]) - lam * bflo(bw[e]); o[h2 * 8 + 2 * e + 1] = bfhi(aw[e]) - lam * bfhi(bw[e]); } }
#pragma unroll
        for (int k = 0; k < 16; ++k) ss += o[k] * o[k];
        ss += __shfl_xor(ss, 1); ss += __shfl_xor(ss, 2); ss += __shfl_xor(ss, 4);
        const float rs = 1.0f / sqrtf(ss * (1.f / 128.f) + 1e-5f);
        v4u w0, w1;
        w0.x = pk2(o[0] * rs * sw[0], o[1] * rs * sw[1]); w0.y = pk2(o[2] * rs * sw[2], o[3] * rs * sw[3]); w0.z = pk2(o[4] * rs * sw[4], o[5] * rs * sw[5]); w0.w = pk2(o[6] * rs * sw[6], o[7] * rs * sw[7]);
        w1.x = pk2(o[8] * rs * sw[8], o[9] * rs * sw[9]); w1.y = pk2(o[10] * rs * sw[10], o[11] * rs * sw[11]); w1.z = pk2(o[12] * rs * sw[12], o[13] * rs * sw[13]); w1.w = pk2(o[14] * rs * sw[14], o[15] * rs * sw[15]);
        v4u* po = (v4u*)(OZ + (size_t)t * 1024 + lane * 16); po[0] = w0; po[1] = w1;
    }
}
#define RLX_AGENT __ATOMIC_RELAXED, __HIP_MEMORY_SCOPE_AGENT
#define LDS_WAIT() asm volatile("s_waitcnt lgkmcnt(0)" ::: "memory")
#define VM_WAIT() asm volatile("s_waitcnt vmcnt(0)" ::: "memory")
__device__ __forceinline__ unsigned long long rt() { return __builtin_amdgcn_s_memrealtime(); }

#define XB_TMO      128
#define XB_XCNT(j)  (256  + 64 * (j))
#define XB_XSUB(j)  (1280 + 64 * (j))
#define XB_XGEN(j)  (2304 + 64 * (j))
#define XB_TOP      3328
#define XB_TOPGEN   3392
#define XCD_BAR_WORDS 3456
#define XB_SPIN_CAP (1u << 18)

__device__ __forceinline__ unsigned xb_ld(unsigned* p)              { return __hip_atomic_load(p, __ATOMIC_RELAXED, __HIP_MEMORY_SCOPE_AGENT); }
__device__ __forceinline__ unsigned xb_add(unsigned* p, unsigned v) { return __hip_atomic_fetch_add(p, v, __ATOMIC_RELAXED, __HIP_MEMORY_SCOPE_AGENT); }
__device__ __forceinline__ unsigned xb_xcc_id() { return (unsigned)__builtin_amdgcn_s_getreg((3 << 11) | 20) & 0xFu; }
#define XB_SPIN(cond, bar) do { unsigned _sp = 0; while (cond) { __builtin_amdgcn_s_sleep(1); \
    if ((++_sp & 255u) == 0u) { if (xb_ld(&(bar)[XB_TMO])) break; if (_sp > XB_SPIN_CAP) { atomicAdd(&(bar)[XB_TMO], 1u); break; } } } } while (0)

struct XcdBarrier {
    unsigned* bar; unsigned x;
    volatile LAS unsigned* st;
};

__device__ __forceinline__ XcdBarrier xcd_barrier_post(unsigned* bar, volatile LAS unsigned* st) {
    XcdBarrier b; b.bar = bar; b.x = xb_xcc_id(); b.st = st;
    if (threadIdx.x == 0) (void)xb_add(&bar[XB_XCNT(b.x)], 1u);
    return b;
}
__device__ __forceinline__ void xcd_barrier_complete(unsigned* bar, unsigned x, unsigned& nloc, unsigned& nx) {
    const unsigned G = gridDim.x * gridDim.y * gridDim.z;
    unsigned sum, cnt, mine, sp = 0u;
    for (;;) {
        sum = 0u; cnt = 0u; mine = 0u;
#pragma unroll
        for (unsigned j = 0; j < 16; ++j) { const unsigned c = xb_ld(&bar[XB_XCNT(j)]); sum += c; cnt += (c > 0u) ? 1u : 0u; mine = (j == x) ? c : mine; }
        if (sum == G) break;
        __builtin_amdgcn_s_sleep(1);
        if ((++sp & 255u) == 0u) { if (xb_ld(&bar[XB_TMO])) break; if (sp > XB_SPIN_CAP) { atomicAdd(&bar[XB_TMO], 1u); break; } }
    }
    nloc = mine > 0u ? mine : 1u; nx = cnt > 0u ? cnt : 1u;
}

__device__ __forceinline__ void xcd_barrier(const XcdBarrier& b) {
    asm volatile("s_waitcnt vmcnt(0)" ::: "memory");
    __syncthreads();
    if (threadIdx.x == 0) {
        unsigned* bar = b.bar;
        __builtin_amdgcn_s_waitcnt(0);
        unsigned nloc = b.st[0], nx = b.st[1];
        if (nloc == 0u) { xcd_barrier_complete(bar, b.x, nloc, nx); b.st[0] = nloc; b.st[1] = nx; }
        const unsigned old = xb_add(&bar[XB_XSUB(b.x)], 1u);
        const unsigned gen = old / nloc;
        if (old + 1u == (gen + 1u) * nloc) {
            __builtin_amdgcn_fence(__ATOMIC_RELEASE, "agent");
            asm volatile("s_waitcnt vmcnt(0)" ::: "memory");
            const unsigned og = xb_add(&bar[XB_TOP], 1u);
            const unsigned tg = og / nx;
            if (og + 1u == (tg + 1u) * nx) xb_add(&bar[XB_TOPGEN], 1u);
            else XB_SPIN(xb_ld(&bar[XB_TOPGEN]) == tg, bar);
            __builtin_amdgcn_fence(__ATOMIC_ACQUIRE, "agent");
            xb_add(&bar[XB_XGEN(b.x)], 1u);
            asm volatile("s_waitcnt vmcnt(0)" ::: "memory");
        } else {
            XB_SPIN(xb_ld(&bar[XB_XGEN(b.x)]) == gen, bar);
            __builtin_amdgcn_fence(__ATOMIC_ACQUIRE, "agent");
            asm volatile("s_waitcnt vmcnt(0)" ::: "memory");
        }
    }
    __syncthreads();
}
#define INP(i) inp_ptr(a, (i))
__global__ void __launch_bounds__(NWAVES * 64, 2) mega_fwd(Args a) {
    extern __shared__ __attribute__((aligned(16))) unsigned char lds[];
    cg::grid_group grid = cg::this_grid();
    LAS unsigned char* ldsl = (LAS unsigned char*)lds;
    const int wave0 = __builtin_amdgcn_readfirstlane(threadIdx.x >> 6);
    volatile LAS unsigned* MISC = (volatile LAS unsigned*)(ldsl + 143360);
    if (threadIdx.x < 16) MISC[threadIdx.x] = 0u;
    __syncthreads();
    XcdBarrier xbar = xcd_barrier_post((unsigned*)a.ws, MISC + 8);
#pragma unroll 1
    for (int pp = a.ph_lo * 2; pp < a.ph_hi * 2; ++pp) {
        const int p = pp >> 1, rep = pp & 1;
        unsigned zs = 0u; asm volatile("" : "+s"(zs));
        const int tid = wave0 * 64 + (int)__builtin_amdgcn_mbcnt_hi(~0u, __builtin_amdgcn_mbcnt_lo(~0u, zs));
        int G = gridDim.x, bx = blockIdx.x; asm volatile("" : "+s"(G), "+s"(bx));
        unsigned char* ws = a.ws; asm volatile("" : "+s"(ws));
        const int wave = wave0;
        const int vcu = (G % 8 == 0) ? (bx % 8) * (G / 8) + bx / 8 : bx;
        const int gw = vcu * NWAVES + wave, NGW = G * NWAVES, NTHR = G * NWAVES * 64;
        LAS float* wl = (LAS float*)(ldsl + wave * 16384);
        bf16* XN = (bf16*)(ws + WS_XN);
        int layer, step;
        if (p < 14) { layer = 0; step = p; } else if (p < 22) { layer = 1; step = p - 14; } else if (p < 36) { layer = 2; step = p - 22; } else if (p < 44) { layer = 3; step = p - 36; } else { layer = 4; step = 0; }
        const bool odd = layer & 1; const int j = layer >> 1;
        const float* ng = INP(2) + (size_t)layer * 4096;
        int kind;
        if (layer == 4) kind = 0;
        else if (!odd) kind = (step == 0 || step == 11) ? 0 : (step == 2) ? 2 : (step == 4) ? 3 : (step == 5) ? 4 : (step == 6) ? 10 : (step == 7) ? 5 : (step == 8) ? 11 : (step == 9) ? 6 : 1;
        else kind = (step == 0 || step == 5) ? 0 : (step == 2) ? 8 : (step == 3) ? 9 : 1;
        if (rep == 1 && !((REP_MASK >> kind) & 1)) continue;
        if (kind == 8) {
            const attn_body::bf16* Qb = (const attn_body::bf16*)(ws + WS_Q); const attn_body::bf16* Kb = (const attn_body::bf16*)(ws + WS_K); const attn_body::bf16* Vb = (const attn_body::bf16*)(ws + WS_V);
            attn_body::bf16* Ob0 = (attn_body::bf16*)(ws + WS_O0); attn_body::bf16* Ob1 = (attn_body::bf16*)(ws + WS_O1);
            const int cpx = G >> 3, xg = vcu / cpx, jx = vcu - xg * cpx;
            for (int r = 0;; ++r) {
                const int ps = r * cpx + ((r & 1) ? (cpx - 1 - jx) : jx); if (ps >= 65 * 2) break;
                const int qb = 64 - (ps >> 1), hh = xg, cc = ps & 1;
                int tid_u = tid; asm volatile("" : "+v"(tid_u));
                attn_body::attn_unit<8>(qb, Qb + hh * 128 + cc * 64, Kb + hh * 128 + cc * 64, Vb + hh * 128, (cc ? Ob1 : Ob0) + hh * 128, (char*)lds, tid_u);
            }
        } else {
        int tid_e = tid; asm volatile("" : "+v"(tid_e));
        const int lane = tid_e & 63, gtid = bx * (NWAVES * 64) + tid_e;
        if (kind == 0) {
            if (layer == 4) norm_rows(2, nullptr, nullptr, a.out, (float*)(ws + WS_HM), (const bf16*)(ws + WS_F), ng - 1024, nullptr, XN, gw, NGW, lane);
            else if (step == 0) {
#pragma unroll 1
                for (int ps_ = 0; ps_ < 2; ++ps_) {
                    if ((ps_ ^ (wave & 1)) == 0) wconv(a, layer, wl, gw, NGW, lane, gtid, NTHR);
                    else norm_rows(layer == 0 ? 0 : 1, INP(0), INP(1), a.out, (float*)(ws + WS_HM), (const bf16*)(ws + WS_F), ng - 1024, ng, XN, gw, NGW, lane);
                }
            } else norm_rows(layer == 0 ? 3 : 1, INP(0), INP(1), a.out, (float*)(ws + WS_HM), (const bf16*)(ws + (odd ? WS_M1O : WS_M1E)), ng + 1024, ng + 2048, XN, gw, NGW, lane);
        } else if (kind == 1) {
            int ng_ = 1;
            const bf16* A0 = XN; const bf16* B0 = (const bf16*)(ws + WS_WIN); int N0 = 2304, K0 = 1024, ldc0 = 2304, act0 = 0, sc0 = 0, rope0 = 0; bf16* O0 = (bf16*)(ws + WS_Y); const float* cs0 = nullptr;
            const bf16* A1 = nullptr; const bf16* B1 = nullptr; int N1 = 0, K1 = 0, ldc1 = 0; bf16* O1 = nullptr; const float* cs1 = nullptr;
            if (!odd) {
                if (step == 3) { ng_ = 2; A0 = (const bf16*)(ws + WS_Z); B0 = (const bf16*)(ws + WS_WLR); N0 = 1536; K0 = 256; ldc0 = 1536; O0 = (bf16*)(ws + WS_LR);
                                 A1 = (const bf16*)(ws + WS_DP); B1 = (const bf16*)(ws + WS_WPOOL); N1 = 512; K1 = 512; ldc1 = 1024; O1 = (bf16*)(ws + WS_OZE) + 512; cs1 = INP(18) + (size_t)j * 512; }
                else if (step == 10) { A0 = (const bf16*)(ws + WS_OZE); B0 = (const bf16*)(ws + WS_WOUT); N0 = 1024; ldc0 = 1024; O0 = (bf16*)(ws + WS_M1E); }
            } else {
                if (step == 1) { N0 = 3072; ldc0 = 1024; sc0 = 1024; O0 = (bf16*)(ws + WS_Q); rope0 = 1; }
                else if (step == 4) { A0 = (const bf16*)(ws + WS_OZO); B0 = (const bf16*)(ws + WS_WOUT); N0 = 1024; ldc0 = 1024; O0 = (bf16*)(ws + WS_M1O); }
            }
            const int mstep = odd ? step - 6 : step - 12;
            if (mstep == 0) { B0 = (const bf16*)(ws + WS_W1); N0 = 4096; ldc0 = 4096; act0 = 1; O0 = (bf16*)(ws + WS_HID); }
            else if (mstep == 1) { A0 = (const bf16*)(ws + WS_HID); B0 = (const bf16*)(ws + WS_W2); N0 = 1024; K0 = 4096; ldc0 = 1024; O0 = (bf16*)(ws + WS_F); }
#pragma unroll 1
            for (int q = 0; q < ng_; ++q) {
                const bf16* Aq = q ? A1 : A0; const bf16* Bq = q ? B1 : B0; bf16* Oq = q ? O1 : O0; const int Nq = q ? N1 : N0, Kq = q ? K1 : K0, ldq = q ? ldc1 : ldc0, scq = q ? 0 : sc0, actq = q ? 0 : act0; const float* csq = q ? cs1 : cs0;
                { int tid_t = tid; asm volatile("" : "+v"(tid_t));
                  thin_gemm(Aq, Bq, Nq, Kq, Oq, ldq, csq, scq, ACT_BYTES / 2, actq, q ? 0 : rope0, (LAS float*)ldsl, vcu, G, tid_t, wave, tid_t & 63); }
                pg8::Gemm g{Aq + (size_t)NMETA * Kq, Bq, 16384, Nq, Kq}; pg8::StaticOrder S; S.init(16384, g.N, G, bx);
                pg8::EpiBf16 E{Oq + (size_t)NMETA * ldq, ldq, csq, scq, ACT_BYTES / 2, actq, q ? 0 : rope0, NMETA};
                { unsigned z3 = 0u; asm volatile("" : "+s"(z3)); const int tid_g = wave0 * 64 + (int)__builtin_amdgcn_mbcnt_hi(~0u, __builtin_amdgcn_mbcnt_lo(~0u, z3));
                  pg8::gemm_phase<pg8::EpiBf16, pg8::StaticOrder, true, true>(ldsl, g, S, E, tid_g); }
            }
            if (rope0) { unsigned z2 = 0u; asm volatile("" : "+s"(z2)); const int tid_z = wave0 * 64 + (int)__builtin_amdgcn_mbcnt_hi(~0u, __builtin_amdgcn_mbcnt_lo(~0u, z2));
                zero_pad_rows((bf16*)(ws + WS_Q), (bf16*)(ws + WS_K), (bf16*)(ws + WS_V), bx * (NWAVES * 64) + tid_z, NTHR); }
        } else if (kind == 2) {
            shift_rows((const bf16*)(ws + WS_Y), INP(6) + (size_t)j * 1792, (bf16*)(ws + WS_REC), (bf16*)(ws + WS_Z), (bf16*)(ws + WS_DP), gw, NGW, lane);
        } else if (kind == 3) {
            prep_rows((const bf16*)(ws + WS_LR), (bf16*)(ws + WS_REC), (float*)(ws + WS_BON), INP(7) + j * 512, INP(9) + j * 512, INP(12) + j * 512, INP(13) + j * 512, INP(14) + j * 512, gw, NGW, lane);
        } else if (kind == 4) {
            scan1((const bf16*)(ws + WS_REC), (float*)(ws + WS_PP), (bf16*)(ws + WS_PRQ), wl, gw, NGW, lane);
        } else if (kind == 10) {
            if (vcu >= 128) wconv_mlp(a, layer, 1, wl, (vcu - 128) * NWAVES + wave, (G - 128) * NWAVES, lane);
            if (vcu < 128) { const int g = vcu >> 3, hh = vcu & 7; float* PPf = (float*)(ws + WS_PP);
                chain<4>(PPf + ((size_t)(8 * g * 8 + hh) * 2) * 4096, (size_t)8 * 2 * 4096, 8, nullptr, nullptr, 0, (float*)(ws + WS_GPP) + ((size_t)(g * 8 + hh) * 2) * 4096, (LAS float*)ldsl, tid, wave, lane); }
        } else if (kind == 5) {
            if (vcu >= 8) wconv_mlp(a, layer, 0, wl, (vcu - 8) * NWAVES + wave, (G - 8) * NWAVES, lane);
            if (vcu < 8) { const int hh = vcu; float* PPf = (float*)(ws + WS_PP);
                chain<2>((const float*)(ws + WS_GPP) + ((size_t)hh * 2) * 4096, (size_t)8 * 2 * 4096, 16, nullptr, PPf + ((size_t)(7 * 8 + hh) * 2 + 1) * 4096, (size_t)64 * 2 * 4096, nullptr, (LAS float*)ldsl, tid, wave, lane); }
        } else if (kind == 11) {
            if (vcu >= 128) wconv_mlp(a, layer, 2, wl, (vcu - 128) * NWAVES + wave, (G - 128) * NWAVES, lane);
            if (vcu < 128) { const int g = vcu >> 3, hh = vcu & 7; float* PPf = (float*)(ws + WS_PP);
                chain<2>(PPf + ((size_t)(8 * g * 8 + hh) * 2) * 4096, (size_t)8 * 2 * 4096, 7, g ? PPf + ((size_t)((8 * g - 1) * 8 + hh) * 2 + 1) * 4096 : nullptr, PPf + ((size_t)(8 * g * 8 + hh) * 2 + 1) * 4096, (size_t)8 * 2 * 4096, nullptr, (LAS float*)ldsl, tid, wave, lane); }
        } else if (kind == 6) {
            scan_out((const bf16*)(ws + WS_REC), (const float*)(ws + WS_PP), (const bf16*)(ws + WS_PRQ), (const float*)(ws + WS_BON), INP(15) + j * 512, INP(16) + j * 512, (bf16*)(ws + WS_OZE), vcu, G, wave, lane);
        } else {
            combine_rows((const bf16*)(ws + WS_O0), (const bf16*)(ws + WS_O1), INP(21) + j * 256, INP(22) + j * 128, 0.8f - 0.6f * expf(-0.3f * (float)layer), (bf16*)(ws + WS_OZO), gw, NGW, lane);
        }
        }
        if ((rep == 1 || !((REP_MASK >> kind) & 1)) && p + 1 < a.ph_hi) {
            if (p == a.ph_lo) grid.sync();
            else xcd_barrier(xbar);
        }
    }
}

extern "C" void kernel_launch(void* const* d_in, const int* in_sizes, int n_in, void* d_out, int out_size, void* d_ws, size_t ws_size, hipStream_t stream) {
    static int grid = 0;
    if (grid == 0) {
        if (n_in != 24 || out_size != 16384 * 1024 || ws_size < WS_END) { fprintf(stderr, "kernel_launch: unexpected shapes: n_in %d out %d ws %zu; nothing launched\n", n_in, out_size, ws_size); grid = -1; return; }
        int dev = 0, cus = 0, per_cu = 0;
        if (hipGetDevice(&dev) != hipSuccess || hipDeviceGetAttribute(&cus, hipDeviceAttributeMultiprocessorCount, dev) != hipSuccess) { grid = -1; return; }
        if (hipFuncSetAttribute((const void*)mega_fwd, hipFuncAttributeMaxDynamicSharedMemorySize, LDS_BYTES) != hipSuccess) { fprintf(stderr, "kernel_launch: hipFuncSetAttribute failed\n"); grid = -1; return; }
        if (hipOccupancyMaxActiveBlocksPerMultiprocessor(&per_cu, (const void*)mega_fwd, NWAVES * 64, LDS_BYTES) != hipSuccess || per_cu < 1) { fprintf(stderr, "kernel_launch: occupancy query says %d blocks per CU\n", per_cu); per_cu = 1; }
        (void)hipGetLastError();
        grid = cus;
    }
    if (grid < 0) return;
    if (hipMemsetAsync(d_ws, 0, 16384, stream) != hipSuccess) { fprintf(stderr, "kernel_launch: hipMemsetAsync failed\n"); return; }
    Args a{};
    for (int i = 0; i < 24; ++i) a.in[i] = (const float*)d_in[i];
    a.out = (float*)d_out; a.ws = (unsigned char*)d_ws;
#if MK_SINGLE
    a.ph_lo = 0; a.ph_hi = NPH;
    void* args[] = {&a};
    hipError_t e = hipLaunchCooperativeKernel((const void*)mega_fwd, dim3(grid), dim3(NWAVES * 64), args, LDS_BYTES, stream);
    if (e != hipSuccess) fprintf(stderr, "kernel_launch: cooperative launch failed: %s (grid %d)\n", hipGetErrorString(e), grid);
#else
    for (int p = 0; p < NPH; ++p) { a.ph_lo = p; a.ph_hi = p + 1; hipLaunchKernelGGL(mega_fwd, dim3(grid), dim3(NWAVES * 64), LDS_BYTES, stream, a); }
#endif
}
```

```cpp
#include <hip/hip_runtime.h>
#include <hip/hip_cooperative_groups.h>
#include <cstdio>
#include <cstdint>
namespace cg = cooperative_groups;
#define MK_SINGLE 1
#define REP_MASK 0
#define BAR_TWICE 0
namespace pg8 {
#define PG8_LAS __attribute__((address_space(3)))
typedef unsigned short bf16_t;
typedef short bf16x8 __attribute__((ext_vector_type(8)));
typedef float f32x4 __attribute__((ext_vector_type(4)));
typedef unsigned u32x4 __attribute__((ext_vector_type(4)));
constexpr int BM = 256, BK = 64, HALF = 128, HTB = HALF * BK * 2  , STAGE_BYTES = 8 * HTB, NXCD = 8, WGM = 8;

__host__ __device__ __forceinline__ int lds_byte(int r, int c) { const int st = (r >> 4) * 2 + (c >> 5), rr = r & 15, cc = c & 31, ob = rr * 64 + cc * 2; return st * 1024 + (ob ^ (((ob >> 9) & 1) << 5)); }
__host__ __device__ __forceinline__ void stage_rc(int b, int& R, int& C) { const int st = b / 1024, sb = b % 1024, swz = sb ^ (((sb >> 9) & 1) << 5); R = (st >> 1) * 16 + swz / 64; C = (st & 1) * 32 + (swz % 64) / 2; }
__host__ __device__ __forceinline__ int perm32(int rho) { const int n = rho >> 4, i = rho & 15; return 8 * (i >> 2) + 4 * n + (i & 3); }

struct Unit { int pm, pn; };
struct Gemm { const bf16_t* A; const bf16_t* Bt; int M, N, K; };

struct StaticOrder {
    int nM, nN, nwg, G, c;
    __host__ __device__ void init(int M, int N, int G_, int c_) { nM = M / BM; nN = N / BM; nwg = nM * nN; G = G_; c = c_; }
    __host__ __device__ bool next(int i, Unit& u) const {
        const long L = (long)i * G + c; if (L >= nwg) return false;
        int wgid = (int)L; { const int q = nwg / NXCD, r = nwg % NXCD, xcd = wgid % NXCD, off = wgid / NXCD; wgid = (xcd < r ? xcd * (q + 1) : r * (q + 1) + (xcd - r) * q) + off; }
        const int nig = WGM * nN, gid = wgid / nig, fm = gid * WGM, gsz = (nM - fm) < WGM ? (nM - fm) : WGM;
        u.pm = fm + ((wgid % nig) % gsz); u.pn = (wgid % nig) / gsz; return true;
    }
    __device__ __forceinline__ void a_ready(const Unit&) const {}
    __device__ __forceinline__ void done(const Unit&) const {}
};

__device__ __forceinline__ unsigned cvt_pk_bf16(float lo, float hi) { unsigned r; asm volatile("v_cvt_pk_bf16_f32 %0, %1, %2" : "=v"(r) : "v"(lo), "v"(hi)); return r; }
typedef float f32x2 __attribute__((ext_vector_type(2)));
struct EpiBf16 {
    static constexpr bool PERM = true, AFTER_DRAIN = false;
    bf16_t* O; int ldc; const float* cscale; int split_cols; size_t split_stride; int act; int rope  ; int pos_off;
    __device__ __forceinline__ void operator()(const f32x4 (&acc)[2][2][4][2], const Unit& u, int wr, int wc, int fr, int fq) const {
        const int row0 = u.pm * BM + wr * 64 + fr; int colt = u.pn * BM; bf16_t* base = O;
        int tsel = 0; if (split_cols) { const int t = colt / split_cols; base += (size_t)t * split_stride; colt -= t * split_cols; tsel = t; }
        const bool do_rope = rope && tsel < 2; const float qs = (do_rope && tsel == 0) ? 0.18033688011112042f : 1.f;
        const int col0 = colt + wc * 32 + 8 * fq, ccol0 = u.pn * BM + wc * 32 + 8 * fq;
        const __amdgpu_buffer_rsrc_t orsrc = __builtin_amdgcn_make_buffer_rsrc((void*)base, (short)0, 0x7fffffff, 0x00020000);
        f32x4 sv[2][2];
#pragma unroll
        for (int bj = 0; bj < 2; ++bj)
#pragma unroll
            for (int n = 0; n < 2; ++n) sv[bj][n] = cscale ? *(const f32x4*)(cscale + ccol0 + bj * HALF + 4 * n) : (f32x4){1.f, 1.f, 1.f, 1.f};
#pragma unroll
        for (int ai = 0; ai < 2; ++ai)
#pragma unroll
            for (int m = 0; m < 4; ++m) { const int roff = ((row0 + ai * HALF + m * 16) * ldc + col0) * 2;
#pragma unroll
                for (int bj = 0; bj < 2; ++bj) { f32x4 v0 = acc[ai][bj][m][0], v1 = acc[ai][bj][m][1];
                    if (do_rope) { const float pos = (float)(row0 + ai * HALF + m * 16 + pos_off); const int j0 = ((col0 + bj * HALF) & 63) >> 1;
#pragma unroll
                        for (int e2 = 0; e2 < 4; ++e2) { const float inv = expf(-(float)(j0 + e2) * (9.210340371976184f / 32.f)); const float ang = pos * inv; const double rev = (double)ang * 0.15915494309189535; const float fr_ = (float)(rev - __builtin_rint(rev));
                            const float cs = __builtin_amdgcn_cosf(fr_) * qs, sn = __builtin_amdgcn_sinf(fr_) * qs;
                            if (e2 < 2) { const float x1 = v0[2 * e2], x2 = v0[2 * e2 + 1]; v0[2 * e2] = x1 * cs - x2 * sn; v0[2 * e2 + 1] = x2 * cs + x1 * sn; }
                            else { const float x1 = v1[2 * e2 - 4], x2 = v1[2 * e2 - 3]; v1[2 * e2 - 4] = x1 * cs - x2 * sn; v1[2 * e2 - 3] = x2 * cs + x1 * sn; } } }
                    if (act == 1) {
#pragma unroll
                        for (int e = 0; e < 4; ++e) { const float a = fmaxf(v0[e], 0.f), b = fmaxf(v1[e], 0.f); v0[e] = a * a; v1[e] = b * b; } }
                    v0 = v0 * sv[bj][0]; v1 = v1 * sv[bj][1]; u32x4 w; w.x = cvt_pk_bf16(v0[0], v0[1]); w.y = cvt_pk_bf16(v0[2], v0[3]); w.z = cvt_pk_bf16(v1[0], v1[1]); w.w = cvt_pk_bf16(v1[2], v1[3]);
                    __builtin_amdgcn_raw_buffer_store_b128(w, orsrc, roff + bj * HALF * 2, 0, 16); } }
    }
};
template <class Epi, class Sched, bool ALIGN_EPI = false, bool SP2 = false>
__device__ __forceinline__ void gemm_phase(PG8_LAS unsigned char* lds, const Gemm g, const Sched& S, const Epi& E, const int tid) {
    const int wid = __builtin_amdgcn_readfirstlane(tid >> 6), lane = tid & 63, wr = wid >> 2, wc = wid & 3, fr = lane & 15, fq = lane >> 4;
    const int K = g.K, nt = K / BK;
    unsigned voffA[2], voffB[2];
#pragma unroll
    for (int i = 0; i < 2; ++i) { int R, C; stage_rc(tid * 16 + i * 8192, R, C); const int Rb = Epi::PERM ? ((R & ~31) + perm32(R & 31)) : R;
        voffA[i] = (unsigned)(R * K + C) * 2u; voffB[i] = (unsigned)(Rb * K + C) * 2u; }
    const size_t kstep = (size_t)(BK * 2);
    const size_t hstep = (size_t)HALF * K * 2;
    const size_t tstep = 2 * hstep;
    const unsigned ldsw = (unsigned)wid * 1024u;
    const int aoff = lds_byte(wr * 64 + fr, fq * 8), boff = lds_byte(wc * 32 + fr, fq * 8);
#define PG8_SA(b, h) (((b) * 2 + (h)) * HTB)
#define PG8_SB(b, h) ((4 + (b) * 2 + (h)) * HTB)
#define PG8_STAGE(bufoff, gbase, voff) do { _Pragma("unroll") for (int _i = 0; _i < 2; ++_i) \
        __builtin_amdgcn_global_load_lds((const unsigned*)((const char*)(gbase) + (voff)[_i]), (PG8_LAS unsigned*)(lds + (bufoff) + ldsw + _i * 8192), 16, 0, 0); } while (0)
#define PG8_LDA(dst, b, h) do { _Pragma("unroll") for (int m = 0; m < 4; ++m) _Pragma("unroll") for (int k = 0; k < 2; ++k) dst[m][k] = *(const PG8_LAS bf16x8*)(lds + PG8_SA(b, h) + aoff + m * 2048 + k * 1024); } while (0)
#define PG8_LDB(dst, b, h) do { _Pragma("unroll") for (int n = 0; n < 2; ++n) _Pragma("unroll") for (int k = 0; k < 2; ++k) dst[n][k] = *(const PG8_LAS bf16x8*)(lds + PG8_SB(b, h) + boff + n * 2048 + k * 1024); } while (0)
#define PG8_MMA(ai, bj, At, Bt) do { __builtin_amdgcn_s_setprio(1); _Pragma("unroll") for (int m = 0; m < 4; ++m) _Pragma("unroll") for (int n = 0; n < 2; ++n) _Pragma("unroll") for (int k = 0; k < 2; ++k) \
        acc[ai][bj][m][n] = __builtin_amdgcn_mfma_f32_16x16x32_bf16(Bt[n][k], At[m][k], acc[ai][bj][m][n], 0, 0, 0); __builtin_amdgcn_s_setprio(0); } while (0)
#define PG8_WAIT_V(n) asm volatile("s_waitcnt vmcnt(" #n ")" ::: "memory")
#define PG8_WAIT_L(n) asm volatile("s_waitcnt lgkmcnt(" #n ")" ::: "memory")
#define PG8_BAR __builtin_amdgcn_s_barrier()
#define PG8_SCHED __builtin_amdgcn_sched_barrier(0)
    Unit cur, nxt; int ui = 0;
    if (!S.next(0, cur)) return;
    f32x4 acc[2][2][4][2];
#pragma unroll
    for (int a = 0; a < 2; ++a)
#pragma unroll
        for (int b = 0; b < 2; ++b)
#pragma unroll
            for (int m = 0; m < 4; ++m)
#pragma unroll
                for (int n = 0; n < 2; ++n) acc[a][b][m][n] = (f32x4){0.f, 0.f, 0.f, 0.f};
    bf16x8 At[4][2], B0[2][2], B1[2][2];
    const char* cA = (const char*)g.A + (size_t)cur.pm * tstep; const char* cB = (const char*)g.Bt + (size_t)cur.pn * tstep;
    S.a_ready(cur);
    if constexpr (SP2) {
        PG8_STAGE(PG8_SB(0, 0), cB, voffB); PG8_STAGE(PG8_SB(0, 1), cB + hstep, voffB); PG8_STAGE(PG8_SA(0, 0), cA, voffA); PG8_STAGE(PG8_SA(0, 1), cA + hstep, voffA);
        if (wr == 1) PG8_BAR;
        PG8_WAIT_V(2); PG8_BAR;
        PG8_STAGE(PG8_SB(1, 0), cB + kstep, voffB); PG8_STAGE(PG8_SA(1, 0), cA + kstep, voffA); PG8_STAGE(PG8_SB(1, 1), cB + hstep + kstep, voffB);
        PG8_WAIT_V(6); PG8_BAR;
    } else {
        PG8_STAGE(PG8_SB(0, 0), cB, voffB); PG8_STAGE(PG8_SA(0, 0), cA, voffA); PG8_STAGE(PG8_SB(0, 1), cB + hstep, voffB); PG8_STAGE(PG8_SA(0, 1), cA + hstep, voffA);
        if (wr == 1) PG8_BAR;
        PG8_WAIT_V(4); PG8_BAR;
        PG8_STAGE(PG8_SB(1, 0), cB + kstep, voffB); PG8_STAGE(PG8_SA(1, 0), cA + kstep, voffA); PG8_STAGE(PG8_SB(1, 1), cB + hstep + kstep, voffB);
        PG8_WAIT_V(6); PG8_BAR;
    }
    for (;;) {
        const bool has_next = S.next(ui + 1, nxt);
        const char* nA = has_next ? (const char*)g.A + (size_t)nxt.pm * tstep : cA; const char* nB = has_next ? (const char*)g.Bt + (size_t)nxt.pn * tstep : cB;
        for (int t = 0; t < nt; t += 2) {
            const bool last = (t == nt - 2);
            const char* a1 = cA + (size_t)(t + 1) * kstep;
            const char* a2 = last ? nA : cA + (size_t)(t + 2) * kstep; const char* b2 = last ? nB : cB + (size_t)(t + 2) * kstep;
            const char* a3 = a2 + kstep; const char* b3 = b2 + kstep;
            if (last && has_next) S.a_ready(nxt);
            if constexpr (SP2) {
            PG8_LDB(B0, 0, 0); PG8_LDB(B1, 0, 1); PG8_SCHED; PG8_LDA(At, 0, 0); PG8_STAGE(PG8_SA(1, 1), a1 + hstep, voffA);
            PG8_WAIT_V(8); PG8_WAIT_L(0); PG8_BAR; PG8_MMA(0, 0, At, B0); PG8_MMA(0, 1, At, B1); PG8_BAR; PG8_SCHED;
            PG8_LDA(At, 0, 1); PG8_STAGE(PG8_SB(0, 0), b2, voffB); PG8_STAGE(PG8_SB(0, 1), b2 + hstep, voffB); PG8_STAGE(PG8_SA(0, 0), a2, voffA);
            PG8_WAIT_V(8); PG8_WAIT_L(0); PG8_BAR; PG8_MMA(1, 0, At, B0); PG8_MMA(1, 1, At, B1); PG8_BAR; PG8_SCHED;
            PG8_LDB(B0, 1, 0); PG8_LDB(B1, 1, 1); PG8_SCHED; PG8_LDA(At, 1, 0); PG8_STAGE(PG8_SA(0, 1), a2 + hstep, voffA);
            PG8_WAIT_V(8); PG8_WAIT_L(0); PG8_BAR; PG8_MMA(0, 0, At, B0); PG8_MMA(0, 1, At, B1); PG8_BAR; PG8_SCHED;
            PG8_LDA(At, 1, 1); PG8_STAGE(PG8_SB(1, 0), b3, voffB); PG8_STAGE(PG8_SB(1, 1), b3 + hstep, voffB); PG8_STAGE(PG8_SA(1, 0), a3, voffA);
            PG8_WAIT_V(8); PG8_WAIT_L(0); PG8_BAR; PG8_MMA(1, 0, At, B0); PG8_MMA(1, 1, At, B1); PG8_BAR; PG8_SCHED;
            } else {
            PG8_LDB(B0, 0, 0); PG8_SCHED; PG8_LDA(At, 0, 0); PG8_STAGE(PG8_SA(1, 1), a1 + hstep, voffA);
            PG8_WAIT_L(8); PG8_BAR; PG8_WAIT_L(0); PG8_MMA(0, 0, At, B0); PG8_BAR; PG8_SCHED;
            PG8_LDB(B1, 0, 1); PG8_STAGE(PG8_SB(0, 0), b2, voffB);
            PG8_BAR; PG8_WAIT_L(0); PG8_MMA(0, 1, At, B1); PG8_BAR;
            PG8_LDA(At, 0, 1); PG8_STAGE(PG8_SA(0, 0), a2, voffA);
            PG8_BAR; PG8_WAIT_L(0); PG8_MMA(1, 0, At, B0); PG8_BAR; PG8_SCHED;
            PG8_STAGE(PG8_SB(0, 1), b2 + hstep, voffB);
            PG8_WAIT_V(6); PG8_BAR; PG8_MMA(1, 1, At, B1); PG8_BAR;
            PG8_LDB(B0, 1, 0); PG8_SCHED; PG8_LDA(At, 1, 0); PG8_STAGE(PG8_SA(0, 1), a2 + hstep, voffA);
            PG8_WAIT_L(8); PG8_BAR; PG8_WAIT_L(0); PG8_MMA(0, 0, At, B0); PG8_BAR; PG8_SCHED;
            PG8_LDB(B1, 1, 1); PG8_STAGE(PG8_SB(1, 0), b3, voffB);
            PG8_BAR; PG8_WAIT_L(0); PG8_MMA(0, 1, At, B1); PG8_BAR;
            PG8_LDA(At, 1, 1); PG8_STAGE(PG8_SA(1, 0), a3, voffA);
            PG8_BAR; PG8_WAIT_L(0); PG8_MMA(1, 0, At, B0); PG8_BAR; PG8_SCHED;
            PG8_STAGE(PG8_SB(1, 1), b3 + hstep, voffB);
            PG8_WAIT_V(6); PG8_BAR; PG8_MMA(1, 1, At, B1); PG8_BAR;
            }
        }
        if constexpr (ALIGN_EPI) { if (wr == 0) PG8_BAR; }
        if constexpr (!Epi::AFTER_DRAIN) { E(acc, cur, wr, wc, fr, fq); S.done(cur); }
        if (!has_next) break;
#pragma unroll
        for (int a = 0; a < 2; ++a)
#pragma unroll
            for (int b = 0; b < 2; ++b)
#pragma unroll
                for (int m = 0; m < 4; ++m)
#pragma unroll
                    for (int n = 0; n < 2; ++n) acc[a][b][m][n] = (f32x4){0.f, 0.f, 0.f, 0.f};
        cur = nxt; cA = nA; cB = nB; ++ui;
        if constexpr (ALIGN_EPI) { if (wr == 1) PG8_BAR; }
    }
    PG8_WAIT_V(0);
    if constexpr (!ALIGN_EPI) { if (wr == 0) PG8_BAR; }
    PG8_BAR;
    if constexpr (Epi::AFTER_DRAIN) { E.fused(acc, cur, wr, wc, fr, fq, lds, wid, lane); S.done(cur); }
#undef PG8_SA
#undef PG8_SB
#undef PG8_STAGE
#undef PG8_LDA
#undef PG8_LDB
#undef PG8_MMA
#undef PG8_WAIT_V
#undef PG8_WAIT_L
#undef PG8_BAR
#undef PG8_SCHED
}
}
#define ATTN_STORE16(p,v) asm volatile("global_store_dwordx4 %0, %1, off sc1\n\ts_nop 1" :: "v"(p), "v"(v) : "memory")
#include <hip/hip_bf16.h>
#include <cmath>
namespace attn_body {
using bf16=__hip_bfloat16;
using bf16x8=__attribute__((ext_vector_type(8)))short;
using s16x4=__attribute__((ext_vector_type(4)))short;
using f32x16=__attribute__((ext_vector_type(16)))float;
using u32x4=__attribute__((ext_vector_type(4)))unsigned;
typedef float f32x4_t __attribute__((ext_vector_type(4)));
constexpr int D=64,DM=1024;
constexpr int NW=8,QBLK=32,QB=QBLK*NW,KVBLK=64;
constexpr int ATTN_PITCH=DM, ATTN_UNIT_ROWS=QB;
__device__ __forceinline__ int crow(int r,int hi){return (r&3)+8*(r>>2)+4*hi;}
#define SBAR() __builtin_amdgcn_sched_barrier(0)
__device__ __forceinline__ void cmask(f32x16&p0,f32x16&p1,int jb,int qrel,int hi){
  const float NEG=-INFINITY; int kb=64*jb+4*hi;
  #pragma unroll
  for(int r=0;r<16;++r){int kv=kb+(r&3)+8*(r>>2); if(kv>qrel)p0[r]=NEG; if(kv+32>qrel)p1[r]=NEG;}
}

constexpr int NSLOT=3, SLOTB=8192;
constexpr int LDS_K=0, LDS_V=NSLOT*SLOTB, LDS_V1=2*NSLOT*SLOTB, LDS_WS=3*NSLOT*SLOTB, LDS_QS=LDS_WS+NW*64*4, LDS_OST=LDS_V, LDS_BYTES=LDS_QS+NW*4096;
constexpr float C2=0.125f*1.4426950408889634f;
__device__ __forceinline__ void glds16(const void*gsrc,unsigned lds_dst){unsigned keep;
  asm volatile("s_mov_b32 %0, m0\n\ts_mov_b32 m0, %2\n\ts_nop 0\n\tglobal_load_lds_dwordx4 %1, off\n\ts_mov_b32 m0, %0":"=&s"(keep):"v"(gsrc),"s"(lds_dst):"memory");}
__device__ __forceinline__ float max3f(float a,float b,float c){float r;asm("v_max3_f32 %0, %1, %2, %3":"=v"(r):"v"(a),"v"(b),"v"(c));return r;}
__device__ __forceinline__ float max2f(float a,float b){float r;asm("v_max_f32_e32 %0, %1, %2":"=v"(r):"v"(a),"v"(b));return r;}
__device__ __forceinline__ float fadd_s(float a,float b){float r;asm("v_add_f32_e32 %0, %1, %2":"=v"(r):"v"(a),"v"(b));return r;}
__device__ __forceinline__ float fsub_s(float a,float b){float r;asm("v_sub_f32_e32 %0, %1, %2":"=v"(r):"v"(a),"v"(b));return r;}
typedef float f32x2_t __attribute__((ext_vector_type(2))); typedef __bf16 bf16x2_t __attribute__((ext_vector_type(2)));
__device__ __forceinline__ unsigned cvtpk_s(float lo,float hi){f32x2_t v={lo,hi};bf16x2_t b=__builtin_convertvector(v,bf16x2_t);return __builtin_bit_cast(unsigned,b);}
#define WAIT_BAR(N) asm volatile("s_waitcnt vmcnt(" #N ") lgkmcnt(0)\n\ts_barrier":::"memory")

__device__ __forceinline__ void qkt(f32x16&p0,f32x16&p1,const char*Kslot,const bf16x8*qr,const f32x16&negm,int r32,int hi){
  const char*kb=Kslot+hi*1024+r32*16;
  #pragma unroll
  for(int d0=0;d0<4;++d0){
    const bf16x8 b0=*reinterpret_cast<const bf16x8*>(kb+d0*2048);
    const bf16x8 b1=*reinterpret_cast<const bf16x8*>(kb+d0*2048+512);
    if(d0==0){p0=__builtin_amdgcn_mfma_f32_32x32x16_bf16(b0,qr[0],negm,0,0,0);p1=__builtin_amdgcn_mfma_f32_32x32x16_bf16(b1,qr[0],negm,0,0,0);}
    else{p0=__builtin_amdgcn_mfma_f32_32x32x16_bf16(b0,qr[d0],p0,0,0,0);p1=__builtin_amdgcn_mfma_f32_32x32x16_bf16(b1,qr[d0],p1,0,0,0);}}
}
typedef __attribute__((address_space(3))) const char* lds_cptr;
typedef short v4i16_t __attribute__((ext_vector_type(4)));
__device__ __forceinline__ void kload8(bf16x8*kf,lds_cptr kp){
  kf[0]=*(const __attribute__((address_space(3))) bf16x8*)(kp);      kf[1]=*(const __attribute__((address_space(3))) bf16x8*)(kp+512);
  kf[2]=*(const __attribute__((address_space(3))) bf16x8*)(kp+2048); kf[3]=*(const __attribute__((address_space(3))) bf16x8*)(kp+2560);
  kf[4]=*(const __attribute__((address_space(3))) bf16x8*)(kp+4096); kf[5]=*(const __attribute__((address_space(3))) bf16x8*)(kp+4608);
  kf[6]=*(const __attribute__((address_space(3))) bf16x8*)(kp+6144); kf[7]=*(const __attribute__((address_space(3))) bf16x8*)(kp+6656);
}
__device__ __forceinline__ void kload2(bf16x8*kf,lds_cptr kp,int j){ kf[2*j]=*(const __attribute__((address_space(3))) bf16x8*)(kp+j*2048); kf[2*j+1]=*(const __attribute__((address_space(3))) bf16x8*)(kp+j*2048+512); }
__device__ __forceinline__ s16x4 vtr(lds_cptr p){ return __builtin_bit_cast(s16x4,__builtin_amdgcn_ds_read_tr16_b64_v4i16((__attribute__((address_space(3))) v4i16_t*)p)); }
__device__ __forceinline__ float rowmax(const f32x16&p0,const f32x16&p1){
  float a=max3f(p0[0],p0[1],p1[0]),b=max3f(p0[2],p0[3],p1[1]);a=max3f(a,p1[2],p1[3]);
  #pragma unroll
  for(int r=4;r<16;r+=4){a=max3f(a,p0[r],p0[r+1]);b=max3f(b,p0[r+2],p0[r+3]);a=max3f(a,p1[r],p1[r+1]);b=max3f(b,p1[r+2],p1[r+3]);}
  const float m=max2f(a,b);
  auto rr=__builtin_amdgcn_permlane32_swap(__float_as_uint(m),__float_as_uint(m),false,false);
  return max2f(__uint_as_float(rr[0]),__uint_as_float(rr[1]));
}
__device__ __forceinline__ void pv(f32x16*o,int vb,bf16x8 pa0,bf16x8 pa1,bf16x8 pa2,bf16x8 pa3){
  #pragma unroll
  for(int d0=0;d0<2;++d0){s16x4 lo[4],hi[4];
    #pragma unroll
    for(int ks=0;ks<4;++ks){
      asm volatile("ds_read_b64_tr_b16 %0,%1 offset:%c2":"=&v"(lo[ks]):"v"(vb),"i"(d0*4096+ks*1024):"memory");
      asm volatile("ds_read_b64_tr_b16 %0,%1 offset:%c2":"=&v"(hi[ks]):"v"(vb),"i"(d0*4096+ks*1024+512):"memory");}
    asm volatile("s_waitcnt lgkmcnt(0)":::"memory");SBAR();
    #define PK(k) (bf16x8){lo[k][0],lo[k][1],lo[k][2],lo[k][3],hi[k][0],hi[k][1],hi[k][2],hi[k][3]}
    o[d0]=__builtin_amdgcn_mfma_f32_32x32x16_bf16(pa0,PK(0),o[d0],0,0,0);
    o[d0]=__builtin_amdgcn_mfma_f32_32x32x16_bf16(pa1,PK(1),o[d0],0,0,0);
    o[d0]=__builtin_amdgcn_mfma_f32_32x32x16_bf16(pa2,PK(2),o[d0],0,0,0);
    o[d0]=__builtin_amdgcn_mfma_f32_32x32x16_bf16(pa3,PK(3),o[d0],0,0,0);
    #undef PK
  }
}

#ifndef ATTN_STORE16
#define ATTN_STORE16(p,v) (*(u32x4*)(p)=(v))
#endif
template<int THRL> __device__ __forceinline__ void attn_unit(int qb,const bf16*Qh,const bf16*__restrict__ Kh,const bf16*__restrict__ Vh,bf16*Oh,char*shm,const int tid){
  const int lane=tid&63,r32=lane&31,hi=lane>>5; const int wid=__builtin_amdgcn_readfirstlane(tid>>6);
  const int q0=qb*QB;
  const bf16*Qw=Qh+(long)(q0+wid*QBLK)*DM;
  const unsigned lds0=(unsigned)(uintptr_t)shm;
  float*wsf=(float*)(shm+LDS_WS)+wid*64;
  const bf16*ksrc=Kh+(long)lane*DM+wid*8;
  const bf16*vsrc=Vh+(long)(16*(wid&3)+(lane>>2))*DM+(wid>>2)*32+(lane&3)*8;
  const unsigned kdst=lds0+LDS_K+wid*1024, vdst=lds0+LDS_V+wid*1024;
  #define DMA_K(t,slot) glds16(ksrc+(long)(t)*KVBLK*DM,(unsigned)__builtin_amdgcn_readfirstlane(kdst+(slot)))
  #define DMA_V(t,slot) glds16(vsrc+(long)(t)*KVBLK*DM,(unsigned)__builtin_amdgcn_readfirstlane(vdst+(slot)))
  const bf16*vsrc1=vsrc+64; const unsigned vdst1=lds0+LDS_V1+wid*1024;
  #define DMA_V1(t,slot) glds16(vsrc1+(long)(t)*KVBLK*DM,(unsigned)__builtin_amdgcn_readfirstlane(vdst1+(slot)))
  const int vb0=(int)(lds0+LDS_V)+((lane>>4)&1)*32+(lane&3)*8+(4*hi+((lane&15)>>2))*64;
  const int vb1=vb0+(LDS_V1-LDS_V);
  typedef __attribute__((address_space(3))) f32x4_t* o1ptr_t;
  const char*Kbase=shm+LDS_K; bf16x8 kf[8];
  const lds_cptr shm3=(lds_cptr)shm; const lds_cptr kp0=shm3+LDS_K+hi*1024+r32*16; const lds_cptr vp0=shm3+LDS_V+((lane>>4)&1)*32+(lane&3)*8+(4*hi+((lane&15)>>2))*64;
  const int NT=(q0+QB)/KVBLK;
  DMA_K(0,0);DMA_V(0,0);DMA_V1(0,0);DMA_K(1,SLOTB);
  bf16x8 qr[4];
  #pragma unroll
  for(int d0=0;d0<4;++d0)qr[d0]=*reinterpret_cast<const bf16x8*>(&Qw[(long)r32*DM+d0*16+hi*8]);
  typedef __attribute__((address_space(3))) bf16x8* qptr_t; const qptr_t qlds=(qptr_t)(shm3+LDS_QS+wid*4096)+lane;
  _Pragma("unroll") for(int d0=0;d0<4;++d0)qlds[d0*64]=qr[d0];
  #define QF(d) (qlds[(d)*64])
  float mhat=0.f,l_reg=0.f;f32x16 o[2];o[0]=f32x16{};o[1]=f32x16{};f32x16 o1_[2];o1_[0]=f32x16{};o1_[1]=f32x16{};
 float zf_=0.f;asm volatile("":"+v"(zf_));float nmv=zf_;
  #define NEGM(X) f32x16 X; _Pragma("unroll") for(int r_=0;r_<16;++r_)X[r_]=nmv; asm volatile("":"+v"(X))
  const int qrel=wid*QBLK+r32;
  #define CMASK(P0,P1,t) do{int jb_=(t)-(NT-4); if(jb_>=0)cmask(P0,P1,jb_,qrel,hi);}while(0)
  bool resc=false;
  #define START(P0,P1) do{ const float rm=rowmax(P0,P1); resc=false; \
    { const float dl=rm; mhat=fadd_s(mhat,dl); \
      _Pragma("unroll") for(int r=0;r<16;++r){P0[r]=fsub_s(P0[r],dl);P1[r]=fsub_s(P1[r],dl);} \
      nmv=-mhat; } \
    _Pragma("unroll") for(int r=0;r<16;++r)P0[r]=__builtin_amdgcn_exp2f(P0[r]); }while(0)
  #define RESC() do{ if(resc){ asm volatile("s_waitcnt lgkmcnt(0)":::"memory"); \
      _Pragma("unroll") for(int d_=0;d_<2;++d_) _Pragma("unroll") for(int r=0;r<16;++r){ const float f_=wsf[crow(r,hi)]; o[d_][r]*=f_; o1_[d_][r]*=f_; } } }while(0)
  f32x16 pA0,pA1,pB0,pB1;
  int sl_prev=0,sl_cur=0,sl_next=SLOTB;
  #define ROT() do{sl_prev=sl_cur;sl_cur=sl_next;sl_next=(sl_next==(NSLOT-1)*SLOTB)?0:sl_next+SLOTB;}while(0)
  DMA_K(2,2*SLOTB);
  WAIT_BAR(4);
  { NEGM(ng0_); qkt(pA0,pA1,Kbase,qr,ng0_,r32,hi); }asm volatile("s_nop 15\n\ts_nop 7":"+v"(pA0),"+v"(pA1));CMASK(pA0,pA1,0);
  START(pA0,pA1);
  _Pragma("unroll") for(int r=0;r<16;++r)pA1[r]=__builtin_amdgcn_exp2f(pA1[r]);
  WAIT_BAR(0);
  DMA_K(3,0);DMA_V(1,SLOTB);DMA_V1(1,SLOTB);
  ROT();
  kload8(kf,kp0+sl_cur);
  WAIT_BAR(3);
  s16x4 vlo[8],vhi[8]; u32x4 pw0,pw1,pw2,pw3;
  #define PKW(P,B) cvtpk_s(P[B],P[B+1])
  #define PAF(k) __builtin_bit_cast(bf16x8,pw##k)
  #define VFR(i) (bf16x8){vlo[i][0],vlo[i][1],vlo[i][2],vlo[i][3],vhi[i][0],vhi[i][1],vhi[i][2],vhi[i][3]}
  #define PIN(x) asm volatile("":"+v"(x))
  #define MX3(a,b,c) __builtin_fmaxf(__builtin_fmaxf((a),(b)),(c))
  #define GAPA(MF,A0,A1,A2,A3,W0,W1,PW) do{ MF; sacc+=A0; sacc+=A1; sacc+=A2; sacc+=A3; PIN(sacc); W0; W1; PIN(PW); SBAR(); }while(0)
  #define EX(v) __builtin_amdgcn_exp2f(v)
  #define GAPB(MF,X,B) do{ MF; X[B]=EX(X[B]); X[B+1]=EX(X[B+1]); X[B+2]=EX(X[B+2]); X[B+3]=EX(X[B+3]); PIN(X); SBAR(); }while(0)
  #define GAPB2(MF,X,B) do{ MF; X[B]=EX(X[B]); X[B+1]=EX(X[B+1]); PIN(X); SBAR(); }while(0)
  #define VRD(i) do{ vlo[i]=vtr(vp_+(((i)>>2)*4096+((i)&3)*1024)); vhi[i]=vtr(vp_+(((i)>>2)*4096+((i)&3)*1024+512)); }while(0)
  #define KRD(G,j) do{ if(G){ kload2(kf,kp0+sl_next,j); SBAR(); } }while(0)
  #define VRD1(i) do{ vlo[i]=vtr(vq_+(((i)>>2)*4096+((i)&3)*1024)); vhi[i]=vtr(vq_+(((i)>>2)*4096+((i)&3)*1024+512)); }while(0)
  #define STEP(C0,C1,P0,P1,t,GK,GV,GL) do{ SBAR(); \
    const lds_cptr vp_=vp0+sl_prev; \
    const bf16x8 qa_=QF(0), qb_=QF(1); NEGM(ng_); \
    VRD(0); SBAR(); float sacc=(P0[0]+P0[1]); \
    GAPA(C0=__builtin_amdgcn_mfma_f32_32x32x16_bf16(kf[0],qa_,ng_,0,0,0), P0[2],P0[3],P0[4],P0[5],     pw0[0]=PKW(P0,0), pw0[1]=PKW(P0,2), pw0); \
    VRD(4); SBAR(); GAPA(C1=__builtin_amdgcn_mfma_f32_32x32x16_bf16(kf[1],qa_,ng_,0,0,0), P0[6],P0[7],P0[8],P0[9],     pw0[2]=PKW(P0,4), pw0[3]=PKW(P0,6), pw0); \
    const bf16x8 qc_=QF(2); VRD(1); SBAR(); GAPA(C0=__builtin_amdgcn_mfma_f32_32x32x16_bf16(kf[2],qb_,C0,0,0,0),   P0[10],P0[11],P0[12],P0[13], pw1[0]=PKW(P0,8), pw1[1]=PKW(P0,10), pw1); \
    VRD(5); SBAR(); GAPA(C1=__builtin_amdgcn_mfma_f32_32x32x16_bf16(kf[3],qb_,C1,0,0,0),   P0[14],P0[15],P1[0],P1[1],   pw1[2]=PKW(P0,12),pw1[3]=PKW(P0,14), pw1); \
    const bf16x8 qd_=QF(3); VRD(2); SBAR(); GAPA(C0=__builtin_amdgcn_mfma_f32_32x32x16_bf16(kf[4],qc_,C0,0,0,0),   P1[2],P1[3],P1[4],P1[5],     pw2[0]=PKW(P1,0), pw2[1]=PKW(P1,2), pw2); \
    VRD(6); SBAR(); GAPA(C1=__builtin_amdgcn_mfma_f32_32x32x16_bf16(kf[5],qc_,C1,0,0,0),   P1[6],P1[7],P1[8],P1[9],     pw2[2]=PKW(P1,4), pw2[3]=PKW(P1,6), pw2); \
    VRD(3); SBAR(); GAPA(C0=__builtin_amdgcn_mfma_f32_32x32x16_bf16(kf[6],qd_,C0,0,0,0),   P1[10],P1[11],P1[12],P1[13], pw3[0]=PKW(P1,8), pw3[1]=PKW(P1,10), pw3); \
    VRD(7); SBAR(); GAPA(C1=__builtin_amdgcn_mfma_f32_32x32x16_bf16(kf[7],qd_,C1,0,0,0),   P1[14],P1[15],0.f,0.f,       pw3[2]=PKW(P1,12),pw3[3]=PKW(P1,14), pw3); \
    l_reg+=sacc; \
    if(GK){DMA_K((t)+3,sl_cur);} if(GV){DMA_V((t)+1,sl_next);DMA_V1((t)+1,sl_next);} \
    CMASK(C0,C1,t); \
    { float a=MX3(C0[0],C0[1],C1[0]),b=MX3(C0[2],C0[3],C1[1]); a=MX3(a,C1[2],C1[3]); \
      _Pragma("unroll") for(int r=4;r<16;r+=4){a=MX3(a,C0[r],C0[r+1]);b=MX3(b,C0[r+2],C0[r+3]);a=MX3(a,C1[r],C1[r+1]);b=MX3(b,C1[r+2],C1[r+3]);} \
      float rm=__builtin_fmaxf(a,b); { auto rr=__builtin_amdgcn_permlane32_swap(__float_as_uint(rm),__float_as_uint(rm),false,false); rm=__builtin_fmaxf(__uint_as_float(rr[0]),__uint_as_float(rr[1])); } \
      resc=false; \
      if(__builtin_expect(__any(rm>(float)THRL),0)){ const float dl=__builtin_fmaxf(rm,0.f); mhat+=dl; \
        _Pragma("unroll") for(int r=0;r<16;++r){C0[r]-=dl;C1[r]-=dl;} \
        nmv=-mhat; \
        const float f=__builtin_amdgcn_exp2f(-dl); l_reg*=f; if(hi==0)wsf[r32]=f; resc=true; } } \
    SBAR(); const lds_cptr vq_=vp0+(LDS_V1-LDS_V)+sl_prev; \
    GAPB2(o[0]=__builtin_amdgcn_mfma_f32_32x32x16_bf16(PAF(0),VFR(0),o[0],0,0,0), C0,0); VRD1(0); SBAR(); \
    GAPB2(o[1]=__builtin_amdgcn_mfma_f32_32x32x16_bf16(PAF(0),VFR(4),o[1],0,0,0), C0,2); VRD1(4); SBAR(); \
    KRD(GL,0); GAPB2(o[0]=__builtin_amdgcn_mfma_f32_32x32x16_bf16(PAF(1),VFR(1),o[0],0,0,0), C0,4); VRD1(1); SBAR(); \
    KRD(GL,1); GAPB2(o[1]=__builtin_amdgcn_mfma_f32_32x32x16_bf16(PAF(1),VFR(5),o[1],0,0,0), C0,6); VRD1(5); SBAR(); \
    KRD(GL,2); GAPB2(o[0]=__builtin_amdgcn_mfma_f32_32x32x16_bf16(PAF(2),VFR(2),o[0],0,0,0), C0,8); VRD1(2); SBAR(); \
    KRD(GL,3); GAPB2(o[1]=__builtin_amdgcn_mfma_f32_32x32x16_bf16(PAF(2),VFR(6),o[1],0,0,0), C0,10); VRD1(6); SBAR(); \
    GAPB2(o[0]=__builtin_amdgcn_mfma_f32_32x32x16_bf16(PAF(3),VFR(3),o[0],0,0,0), C0,12); VRD1(3); SBAR(); \
    GAPB2(o[1]=__builtin_amdgcn_mfma_f32_32x32x16_bf16(PAF(3),VFR(7),o[1],0,0,0), C0,14); VRD1(7); SBAR(); \
    GAPB2(o1_[0]=__builtin_amdgcn_mfma_f32_32x32x16_bf16(PAF(0),VFR(0),o1_[0],0,0,0), C1,0); \
    GAPB2(o1_[1]=__builtin_amdgcn_mfma_f32_32x32x16_bf16(PAF(0),VFR(4),o1_[1],0,0,0), C1,2); \
    GAPB2(o1_[0]=__builtin_amdgcn_mfma_f32_32x32x16_bf16(PAF(1),VFR(1),o1_[0],0,0,0), C1,4); \
    GAPB2(o1_[1]=__builtin_amdgcn_mfma_f32_32x32x16_bf16(PAF(1),VFR(5),o1_[1],0,0,0), C1,6); \
    GAPB2(o1_[0]=__builtin_amdgcn_mfma_f32_32x32x16_bf16(PAF(2),VFR(2),o1_[0],0,0,0), C1,8); \
    GAPB2(o1_[1]=__builtin_amdgcn_mfma_f32_32x32x16_bf16(PAF(2),VFR(6),o1_[1],0,0,0), C1,10); \
    GAPB2(o1_[0]=__builtin_amdgcn_mfma_f32_32x32x16_bf16(PAF(3),VFR(3),o1_[0],0,0,0), C1,12); \
    GAPB2(o1_[1]=__builtin_amdgcn_mfma_f32_32x32x16_bf16(PAF(3),VFR(7),o1_[1],0,0,0), C1,14); \
    }while(0)
  int t=1;
  #undef CMASK
  #define CMASK(P0,P1,t) do{}while(0)
  for(;t+5<NT;t+=2){
    STEP(pB0,pB1,pA0,pA1,t,true,true,true);     WAIT_BAR(3); RESC(); ROT();
    STEP(pA0,pA1,pB0,pB1,t+1,true,true,true);   WAIT_BAR(3); RESC(); ROT();
  }
  #undef CMASK
  #define CMASK(P0,P1,t) do{int jb_=(t)-(NT-4); if(jb_>=0)cmask(P0,P1,jb_,qrel,hi);}while(0)
  #define ENDW(tt) do{ if((tt)+3<NT){WAIT_BAR(3);} else if((tt)+2<NT){WAIT_BAR(2);} else {WAIT_BAR(0);} }while(0)
  for(;t+1<NT;t+=2){
    STEP(pB0,pB1,pA0,pA1,t,(t+3<NT),(t+1<NT),(t+1<NT));       ENDW(t);   RESC(); ROT();
    STEP(pA0,pA1,pB0,pB1,t+1,(t+4<NT),(t+2<NT),(t+2<NT));     ENDW(t+1); RESC(); ROT();
  }
  STEP(pB0,pB1,pA0,pA1,NT-1,false,false,false); RESC();
  { float sacc=pB0[0]+pB0[1]; _Pragma("unroll") for(int r=2;r<16;++r)sacc+=pB0[r]; _Pragma("unroll") for(int r=0;r<16;++r)sacc+=pB1[r]; l_reg+=sacc;
    pw0=(u32x4){PKW(pB0,0),PKW(pB0,2),PKW(pB0,4),PKW(pB0,6)};pw1=(u32x4){PKW(pB0,8),PKW(pB0,10),PKW(pB0,12),PKW(pB0,14)};pw2=(u32x4){PKW(pB1,0),PKW(pB1,2),PKW(pB1,4),PKW(pB1,6)};pw3=(u32x4){PKW(pB1,8),PKW(pB1,10),PKW(pB1,12),PKW(pB1,14)};
    SBAR(); pv(o,vb0+sl_cur,PAF(0),PAF(1),PAF(2),PAF(3)); }
  { SBAR(); pv(o1_,vb1+sl_cur,PAF(0),PAF(1),PAF(2),PAF(3)); }
  #undef PKW
  #undef PAF
  #undef VFR
  #undef PIN
  #undef MX3
  #undef GAPA
  #undef GAPB
  #undef EX
  #undef VRD
  #undef KRD
  #undef STEP
  #undef ENDW
  {auto rr=__builtin_amdgcn_permlane32_swap(__float_as_uint(l_reg),__float_as_uint(l_reg),false,false);l_reg=__uint_as_float(rr[0])+__uint_as_float(rr[1]);}
  if(hi==0)wsf[32+r32]=l_reg;asm volatile("s_waitcnt lgkmcnt(0)":::"memory");
  float rli[16];
  #pragma unroll
  for(int r=0;r<16;++r)rli[r]=__builtin_amdgcn_rcpf(wsf[32+crow(r,hi)]);
  bf16*Ow=Oh+(long)(q0+wid*QBLK)*DM;
  asm volatile("s_waitcnt lgkmcnt(0)\n\ts_barrier":::"memory");
  _Pragma("unroll") for(int hf=0;hf<2;++hf)
  { bf16*stg=(bf16*)(shm+LDS_OST)+wid*2048;
    #pragma unroll
    for(int r=0;r<16;++r){const int orow=crow(r,hi);
      #pragma unroll
      for(int d0=0;d0<2;++d0)stg[orow*64+d0*32+r32]=__float2bfloat16((hf?o1_[d0][r]:o[d0][r])*rli[r]);}
    asm volatile("s_waitcnt lgkmcnt(0)":::"memory");
    #pragma unroll
    for(int i=0;i<4;++i){const int row=i*8+(lane>>3),ch=lane&7; const u32x4 v=*(const u32x4*)(stg+row*64+ch*8); ATTN_STORE16(Ow+(long)row*DM+hf*64+ch*8,v);}
    asm volatile("s_waitcnt lgkmcnt(0)":::"memory"); }
  asm volatile("s_waitcnt lgkmcnt(0)\n\ts_barrier":::"memory");
  #undef DMA_K
  #undef DMA_V
  #undef DMA_V1
  #undef QF
  #undef NEGM
  #undef GAPB2
  #undef VRD1
  #undef CMASK
  #undef START
  #undef RESC
  #undef ROT
}
constexpr int ATTN_LDS_BYTES=LDS_BYTES;
#undef SBAR
#undef WAIT_BAR
}
#define LAS __attribute__((address_space(3)))
#define GAS __attribute__((address_space(1)))
typedef unsigned short bf16;
typedef unsigned v4u __attribute__((ext_vector_type(4)));
typedef unsigned v2u __attribute__((ext_vector_type(2)));
typedef float f32x4 __attribute__((ext_vector_type(4)));
#ifndef MK_SINGLE
#define MK_SINGLE 1
#endif
constexpr int NWAVES = 8;
constexpr int L = 16400, LP = 16640, TP = 16512, NCH = 129, CHT = 128, NMETA = 16, NPH = 45;
constexpr size_t MiB = 1u << 20, HMiB = 1u << 19;
constexpr size_t WS_HM = HMiB, WS_WIN = 1 * MiB, WS_WOUT = 7 * MiB, WS_W1 = 9 * MiB, WS_W2 = 17 * MiB, WS_WLR = 25 * MiB, WS_WPOOL = 26 * MiB;
constexpr size_t WS_XN = 27 * MiB, WS_PRQ = 27 * MiB, WS_DP = 27 * MiB, WS_Z = 43 * MiB + HMiB;
constexpr size_t WS_Y = 59 * MiB + HMiB, WS_LR = WS_Y, WS_PP = WS_Y, WS_M1E = WS_Y, WS_F = WS_Y, WS_OZO = WS_Y;
constexpr size_t WS_OZE = 108 * MiB + HMiB, WS_BON = 141 * MiB, WS_REC = 143 * MiB;
constexpr size_t WS_GPP = 92 * MiB;
constexpr size_t WS_Q = 92 * MiB, WS_K = 124 * MiB + HMiB, WS_V = 157 * MiB, WS_O0 = 189 * MiB + HMiB, WS_O1 = 222 * MiB, WS_M1O = 92 * MiB, WS_HID = 92 * MiB;
constexpr size_t WS_END = 256 * MiB;
constexpr size_t ACT_BYTES = (size_t)LP * 1024 * 2;
static_assert(WS_PRQ + (size_t)TP * 8 * 128 * 2 <= WS_Y && WS_REC + (size_t)TP * 8 * 448 * 2 <= WS_END && WS_O1 + ACT_BYTES <= WS_END && WS_HID + 4 * ACT_BYTES <= WS_END, "ws map");
static_assert(WS_Y + (size_t)LP * 2304 * 2 <= WS_REC && WS_LR + (size_t)LP * 1536 * 2 <= WS_OZE && WS_OZE + ACT_BYTES <= WS_BON && WS_K - WS_Q == ACT_BYTES && WS_V - WS_K == ACT_BYTES, "ws map 2");
constexpr int LDS_BYTES = 147456;
constexpr float C2Q = 0.125f * 1.4426950408889634f;

__device__ __forceinline__ unsigned f2bf(float f) { unsigned u = __builtin_bit_cast(unsigned, f); return (u + 0x7fffu + ((u >> 16) & 1u)) >> 16; }
__device__ __forceinline__ unsigned pk2(float lo, float hi) { return f2bf(lo) | (f2bf(hi) << 16); }
__device__ __forceinline__ float bf2f(bf16 b) { return __builtin_bit_cast(float, (unsigned)b << 16); }
__device__ __forceinline__ float bflo(unsigned w) { return __builtin_bit_cast(float, w << 16); }
__device__ __forceinline__ float bfhi(unsigned w) { return __builtin_bit_cast(float, w & 0xffff0000u); }
__device__ __forceinline__ float wave_sum(float v) {
#pragma unroll
    for (int o = 1; o < 64; o <<= 1) v += __shfl_xor(v, o);
    return v;
}
__device__ __forceinline__ void st16_wt(void* p, v4u v) { asm volatile("global_store_dwordx4 %0, %1, off sc1\n\ts_nop 1" :: "v"(p), "v"(v) : "memory"); }
__device__ __forceinline__ void st16_wt(void* p, f32x4 v) { st16_wt(p, __builtin_bit_cast(v4u, v)); }
__device__ __forceinline__ void st8_wt(void* p, v2u v) { asm volatile("global_store_dwordx2 %0, %1, off sc1\n\ts_nop 1" :: "v"(p), "v"(v) : "memory"); }
struct Args { const float* in[24]; float* out; unsigned char* ws; int ph_lo, ph_hi; };
__device__ __forceinline__ const float* inp_ptr(const Args& a, int i) { asm volatile("" : "+s"(i)); return a.in[i]; }

__device__ __forceinline__ void transpose_item(const float* W, int K, int N, bf16* WT, LAS float* scr, int item, int lane, int perm_rows = 0) {
    const int nblk = N / 32, kb = item / nblk, nb = item % nblk, k0 = 64 * kb, n0 = 32 * nb;
#pragma unroll 8
    for (int i = 0; i < 32; ++i) { const int kk = 2 * i + (lane >> 5); scr[kk * 33 + (lane & 31)] = W[(size_t)(k0 + kk) * N + n0 + (lane & 31)]; }
    asm volatile("s_waitcnt lgkmcnt(0)" ::: "memory");
    const int c = lane & 7;
#pragma unroll
    for (int j = 0; j < 4; ++j) { const int n = (lane >> 3) + 8 * j; const LAS float* s = scr + (8 * c) * 33 + n;
        v4u o; o.x = pk2(s[0 * 33], s[1 * 33]); o.y = pk2(s[2 * 33], s[3 * 33]); o.z = pk2(s[4 * 33], s[5 * 33]); o.w = pk2(s[6 * 33], s[7 * 33]);
        int nr = n0 + n; if (nr < perm_rows) { const int d = nr & 63; nr = (nr & ~63) + ((d < 32) ? 2 * d : 2 * (d - 32) + 1); }
        *(v4u*)(WT + (size_t)nr * K + k0 + 8 * c) = o; }
    asm volatile("s_waitcnt lgkmcnt(0)" ::: "memory");
}
__device__ __forceinline__ void wconv(const Args& a, int layer, LAS float* scr, int gw, int NGW, int lane, int gtid, int NTHR) {
    const int j = layer >> 1; const bool odd = layer & 1; unsigned char* ws = a.ws;
    const float* Win = odd ? inp_ptr(a, 20) + (size_t)j * 1024 * 3072 : inp_ptr(a, 5) + (size_t)j * 1024 * 2304; const int Nin = odd ? 3072 : 2304;
    const float* Wout = (odd ? inp_ptr(a, 23) : inp_ptr(a, 19)) + (size_t)j * 1024 * 1024;
    const float* W1 = inp_ptr(a, 3) + (size_t)layer * 1024 * 4096; const float* W2 = inp_ptr(a, 4) + (size_t)layer * 4096 * 1024;
    const int I_in = 16 * (Nin / 32), I_out = 16 * 32, I_1 = 16 * 128, I_2 = 64 * 32;
    const int it_hi = odd ? I_in + I_out + I_1 + I_2 : I_in + I_out;
    for (int it = gw; it < it_hi; it += NGW) {
        int r = it;
        if (r < I_in) { transpose_item(Win, 1024, Nin, (bf16*)(ws + WS_WIN), scr, r, lane, odd ? 2048 : 0); continue; } r -= I_in;
        if (r < I_out) { transpose_item(Wout, 1024, 1024, (bf16*)(ws + WS_WOUT), scr, r, lane); continue; } r -= I_out;
        if (r < I_1) { transpose_item(W1, 1024, 4096, (bf16*)(ws + WS_W1), scr, r, lane); continue; } r -= I_1;
        transpose_item(W2, 4096, 1024, (bf16*)(ws + WS_W2), scr, r, lane);
    }
    if (!odd) {
        const float* w_up = inp_ptr(a, 8) + (size_t)j * 64 * 512; const float* a_up = inp_ptr(a, 10) + (size_t)j * 64 * 512; const float* g_up = inp_ptr(a, 11) + (size_t)j * 128 * 512;
        const float* pw = inp_ptr(a, 17) + (size_t)j * 4 * 128 * 128;
        bf16* WLR = (bf16*)(ws + WS_WLR); bf16* WPL = (bf16*)(ws + WS_WPOOL);
        for (int idx = gtid; idx < 1536 * 256; idx += NTHR) { const int n = idx >> 8, k = idx & 255; float v = 0.f;
            if (n < 512) { if (k < 64) v = w_up[k * 512 + n]; }
            else if (n < 1024) { if (k >= 64 && k < 128) v = a_up[(k - 64) * 512 + (n - 512)]; }
            else { if (k >= 128) v = g_up[(k - 128) * 512 + (n - 1024)]; }
            WLR[idx] = (bf16)f2bf(v); }
        for (int idx = gtid; idx < 512 * 512; idx += NTHR) { const int n = idx >> 9, k = idx & 511; const int g = n >> 7; float v = 0.f;
            if ((k >> 7) == g) v = pw[((size_t)g * 128 + (k & 127)) * 128 + (n & 127)];
            WPL[idx] = (bf16)f2bf(v); }
    }
}
__device__ __forceinline__ void wconv_mlp(const Args& a, int layer, int part, LAS float* scr, int widx, int nwork, int lane) {
    unsigned char* ws = a.ws;
    if (part == 0) { const float* W1 = inp_ptr(a, 3) + (size_t)layer * 1024 * 4096;
        for (int it = widx; it < 16 * 128; it += nwork) transpose_item(W1, 1024, 4096, (bf16*)(ws + WS_W1), scr, it, lane); }
    else { const float* W2 = inp_ptr(a, 4) + (size_t)layer * 4096 * 1024;
        for (int it = (part - 1) * 1024 + widx; it < part * 1024; it += nwork) transpose_item(W2, 4096, 1024, (bf16*)(ws + WS_W2), scr, it, lane); }
}
typedef short bf16x8_t __attribute__((ext_vector_type(8)));
__device__ __forceinline__ void thin_gemm(const bf16* A, const bf16* Bt, int N, int K, bf16* O, int ldc, const float* cscale, int split_cols, size_t split_stride, int act, int rope, LAS float* red, int vcu, int G, int tid, int wave, int lane) {
    const int ntile = N >> 4, ks = K >> 3, lr = lane & 15, lq = lane >> 4;
    for (int tile = vcu; tile < ntile; tile += G) {
        const bf16* ap = A + (size_t)lr * K + wave * ks + 8 * lq; const bf16* bp = Bt + (size_t)(tile * 16 + lr) * K + wave * ks + 8 * lq;
        f32x4 acc = {0.f, 0.f, 0.f, 0.f};
        for (int k = 0; k < ks; k += 32) { const bf16x8_t av = *(const bf16x8_t*)(ap + k), bv = *(const bf16x8_t*)(bp + k); acc = __builtin_amdgcn_mfma_f32_16x16x32_bf16(av, bv, acc, 0, 0, 0); }
#pragma unroll
        for (int r = 0; r < 4; ++r) red[wave * 256 + (4 * lq + r) * 16 + lr] = acc[r];
        __syncthreads();
        if (tid < 256) { float s = 0.f;
#pragma unroll
            for (int w = 0; w < 8; ++w) s += red[w * 256 + tid];
            const int m = tid >> 4; int col = tile * 16 + (tid & 15);
            if (act == 1) { s = fmaxf(s, 0.f); s = s * s; }
            if (cscale) s *= cscale[col];
            bf16* base = O; int tsel = 0; if (split_cols) { const int tt = col / split_cols; base += (size_t)tt * split_stride; col -= tt * split_cols; tsel = tt; }
            { const float other = __shfl_xor(s, 1);
              if (rope && tsel < 2) { const int jj = (col & 63) >> 1; const float inv = expf(-(float)jj * (9.210340371976184f / 32.f)); const float ang = (float)m * inv; const double rev = (double)ang * 0.15915494309189535; const float fr_ = (float)(rev - __builtin_rint(rev));
                  const float qs = tsel == 0 ? 0.18033688011112042f : 1.f; const float cs = __builtin_amdgcn_cosf(fr_) * qs, sn = __builtin_amdgcn_sinf(fr_) * qs;
                  s = (col & 1) ? (s * cs + other * sn) : (s * cs - other * sn); } }
            base[(size_t)m * ldc + col] = (bf16)f2bf(s); }
        __syncthreads();
    }
}
__device__ __forceinline__ void norm_rows(int mode, const float* xin, const float* meta, float* out, float* hm, const bf16* Msrc, const float* ga, const float* gb, bf16* XN, int gw, int NGW, int lane) {
    for (int t = gw; t < L; t += NGW) {
        v2u* xo = (v2u*)(XN + (size_t)t * 1024) + lane;
        if (mode == 2 && t < NMETA) continue;
        float* hrow = t < NMETA ? hm + (size_t)t * 1024 : out + (size_t)(t - NMETA) * 1024;
        f32x4 v[4];
        const float* hsrc = (mode == 0 || mode == 3) ? (t < NMETA ? meta + (size_t)t * 1024 : xin + (size_t)(t - NMETA) * 1024) : hrow;
        if (mode == 0) {
#pragma unroll
            for (int j = 0; j < 4; ++j) v[j] = ((const f32x4*)hsrc)[lane + 64 * j]; }
        else { const v2u* mp = (const v2u*)(Msrc + (size_t)t * 1024) + lane; f32x4 m[4]; float ss = 0.f;
#pragma unroll
            for (int j = 0; j < 4; ++j) { const v2u w = mp[64 * j]; m[j] = (f32x4){bflo(w.x), bfhi(w.x), bflo(w.y), bfhi(w.y)}; ss += (m[j].x * m[j].x + m[j].y * m[j].y) + (m[j].z * m[j].z + m[j].w * m[j].w); }
            const float rs = 1.0f / sqrtf(wave_sum(ss) * (1.f / 1024.f) + 1e-6f);
#pragma unroll
            for (int j = 0; j < 4; ++j) { const f32x4 g = ((const f32x4*)ga)[lane + 64 * j]; const f32x4 hv = ((const f32x4*)hsrc)[lane + 64 * j]; v[j] = hv + m[j] * rs * g; st16_wt((f32x4*)hrow + lane + 64 * j, v[j]); } }
        if (mode != 2) { float s2 = 0.f;
#pragma unroll
            for (int j = 0; j < 4; ++j) s2 += (v[j].x * v[j].x + v[j].y * v[j].y) + (v[j].z * v[j].z + v[j].w * v[j].w);
            const float r2 = 1.0f / sqrtf(wave_sum(s2) * (1.f / 1024.f) + 1e-6f);
#pragma unroll
            for (int j = 0; j < 4; ++j) { const f32x4 g = ((const f32x4*)gb)[lane + 64 * j]; const f32x4 o = v[j] * r2 * g; st8_wt(xo + 64 * j, (v2u){pk2(o.x, o.y), pk2(o.z, o.w)}); } }
    }
}
__device__ __forceinline__ void unpack8(const v4u w, float (&f)[8]) { f[0] = bflo(w.x); f[1] = bfhi(w.x); f[2] = bflo(w.y); f[3] = bfhi(w.y); f[4] = bflo(w.z); f[5] = bfhi(w.z); f[6] = bflo(w.w); f[7] = bfhi(w.w); }
__device__ __forceinline__ v4u pack8(const float (&f)[8]) { v4u o; o.x = pk2(f[0], f[1]); o.y = pk2(f[2], f[3]); o.z = pk2(f[4], f[5]); o.w = pk2(f[6], f[7]); return o; }
__device__ __forceinline__ void shift_rows(const bf16* Y, const float* mu, bf16* REC, bf16* Z, bf16* DP, int gw, int NGW, int lane) {
    for (int t = gw; t < L; t += NGW) {
        const bf16* y = Y + (size_t)t * 2304; const bool hp = t > 0;
        v4u cur[4], prv[4];
#pragma unroll
        for (int q = 0; q < 4; ++q) { const int ci = q * 64 + lane; const bool ok = ci < 224;
            cur[q] = ok ? *(const v4u*)(y + 8 * ci) : (v4u){0u, 0u, 0u, 0u}; prv[q] = (ok && hp) ? *(const v4u*)(y - 2304 + 8 * ci) : (v4u){0u, 0u, 0u, 0u}; }
        float ps[8] = {0.f, 0.f, 0.f, 0.f, 0.f, 0.f, 0.f, 0.f}, pc[8];
        { const int win = 2 << (lane >> 4); const int n = (t + 1) < win ? (t + 1) : win; const bf16* yp = y + 1792 + 8 * lane;
          { float f[8]; unpack8(*(const v4u*)yp, f);
#pragma unroll
            for (int e = 0; e < 8; ++e) { pc[e] = f[e]; ps[e] = f[e]; } }
          for (int s = 1; s < n; ++s) { float f[8]; unpack8(*(const v4u*)(yp - (ptrdiff_t)s * 2304), f);
#pragma unroll
            for (int e = 0; e < 8; ++e) ps[e] += f[e]; }
          const float rn = 1.f / (float)n; float o[8];
#pragma unroll
          for (int e = 0; e < 8; ++e) o[e] = ps[e] * rn - pc[e];
          *(v4u*)(DP + (size_t)t * 512 + 8 * lane) = pack8(o); }
#pragma unroll
        for (int q = 0; q < 4; ++q) { const int ci = q * 64 + lane; if (ci < 224) {
            const int c0 = 8 * ci; float a[8], b[8], o[8]; unpack8(cur[q], a); unpack8(prv[q], b);
            const f32x4 m0 = *(const f32x4*)(mu + c0), m1 = *(const f32x4*)(mu + c0 + 4); const float mm[8] = {m0.x, m0.y, m0.z, m0.w, m1.x, m1.y, m1.z, m1.w};
#pragma unroll
            for (int e = 0; e < 8; ++e) o[e] = a[e] + (b[e] - a[e]) * mm[e];
            if (c0 < 1536) { if (t < TP) { const int vec = c0 >> 9, hh = (c0 & 511) >> 6, i0 = c0 & 63; const int slot = vec == 0 ? 0 : (vec == 1 ? 2 : 3);
                    *(v4u*)(REC + (((size_t)hh * TP + t) * 7 + slot) * 64 + i0) = pack8(o); } }
            else { const int zc = c0 - 1536;
                if (zc < 64) {
#pragma unroll
                    for (int e = 0; e < 8; ++e) o[e] = tanhf(o[e]); }
                else if (zc >= 128) {
#pragma unroll
                    for (int e = 0; e < 8; ++e) o[e] = 1.f / (1.f + __expf(-o[e])); }
                *(v4u*)(Z + (size_t)t * 256 + zc) = pack8(o); } } }
    }
}
__device__ __forceinline__ void prep_rows(const bf16* LR, bf16* REC, float* BON, const float* w0, const float* a0, const float* k_k, const float* k_a, const float* r_k, int gw, int NGW, int lane) {
    const int hh = lane >> 3, i0 = (lane & 7) * 8, c0 = hh * 64 + i0;
    float pw0[8], pa0[8], pkk[8], pka[8], prk[8];
#pragma unroll
    for (int e = 0; e < 8; ++e) { pw0[e] = w0[c0 + e]; pa0[e] = a0[c0 + e]; pkk[e] = k_k[c0 + e]; pka[e] = k_a[c0 + e]; prk[e] = r_k[c0 + e]; }
    for (int t = gw; t < L; t += NGW) {
        bf16* rec = REC + ((size_t)hh * TP + t) * 448 + i0; const bf16* lr = LR + (size_t)t * 1536 + c0;
        float r[8], kr[8], lw[8], la[8], lg[8];
        unpack8(*(const v4u*)rec, r); unpack8(*(const v4u*)(rec + 128), kr); unpack8(*(const v4u*)lr, lw); unpack8(*(const v4u*)(lr + 512), la); unpack8(*(const v4u*)(lr + 1024), lg);
        float ev[8], kv[8], kk[8], bb[8]; float nsq = 0.f, bon = 0.f;
#pragma unroll
        for (int e = 0; e < 8; ++e) {
            const float nx = -(pw0[e] + lw[e]); const float sp = fmaxf(nx, 0.f) + log1pf(__expf(-fabsf(nx)));
            ev[e] = __expf(-sp - 0.5f);
            const float av = 1.f / (1.f + __expf(-(pa0[e] + la[e])));
            kk[e] = kr[e] * pkk[e]; nsq += kk[e] * kk[e];
            kv[e] = kr[e] * (1.f + (av - 1.f) * pka[e]); bon += r[e] * kv[e] * prk[e]; bb[e] = av; }
        nsq += __shfl_xor(nsq, 1); nsq += __shfl_xor(nsq, 2); nsq += __shfl_xor(nsq, 4);
        bon += __shfl_xor(bon, 1); bon += __shfl_xor(bon, 2); bon += __shfl_xor(bon, 4);
        const float rn = 1.f / fmaxf(sqrtf(nsq), 1e-12f);
#pragma unroll
        for (int e = 0; e < 8; ++e) { kk[e] *= rn; bb[e] *= kk[e]; }
        *(v4u*)(rec + 64) = pack8(ev); *(v4u*)(rec + 128) = pack8(kv); *(v4u*)(rec + 256) = pack8(kk); *(v4u*)(rec + 320) = pack8(bb); *(v4u*)(rec + 384) = pack8(lg);
        if ((lane & 7) == 0) BON[hh * TP + t] = bon;
    }
}
__device__ __forceinline__ void scan_stage(const bf16* rec_h, int t0, LAS float* wl, int lane) {
    const v4u* src = (const v4u*)(rec_h + (size_t)t0 * 448);
#pragma unroll
    for (int q = 0; q < 7; ++q) {
        const int ci = q * 64 + lane; const v4u raw = src[ci]; const bool isw = ((ci % 56) >> 3) == 1;
        float f[8] = {bflo(raw.x), bfhi(raw.x), bflo(raw.y), bfhi(raw.y), bflo(raw.z), bfhi(raw.z), bflo(raw.w), bfhi(raw.w)};
        if (isw) {
#pragma unroll
            for (int e = 0; e < 8; ++e) f[e] = __expf(-f[e]); }
        LAS f32x4* dst = (LAS f32x4*)(wl + ci * 8);
        dst[0] = (f32x4){f[0], f[1], f[2], f[3]}; dst[1] = (f32x4){f[4], f[5], f[6], f[7]};
    }
}
__device__ __forceinline__ float half_sum(float x) { return x + __shfl_xor(x, 32); }
__device__ __forceinline__ void scan1(const bf16* REC, float* PP, bf16* PRQ, LAS float* wl, int gw, int NGW, int lane) {
    for (int task = gw; task < NCH * 16; task += NGW) {
        asm volatile("" : "+v"(lane));
        const int c = task >> 4, hh = (task >> 1) & 7, rh = task & 1, kh = lane >> 5, row = 32 * rh + (lane & 31); const bf16* rec_h = REC + (size_t)hh * TP * 448;
        float P[32], Q[32];
#pragma unroll
        for (int k = 0; k < 32; ++k) { P[k] = (32 * kh + k == row) ? 1.f : 0.f; Q[k] = 0.f; }
        const int tend = (c + 1) * CHT < L ? (c + 1) * CHT : L;
        for (int t0 = c * CHT; t0 < tend; t0 += 8) {
            scan_stage(rec_h, t0, wl, lane);
#pragma unroll 1
            for (int s = 0; s < 8; ++s) {
                const LAS float* b = wl + s * 448 + 32 * kh; const float vv = wl[s * 448 + 192 + row];
                f32x4 kk8[8], w8[8], b8[8], k8[8];
#pragma unroll
                for (int q = 0; q < 8; ++q) kk8[q] = *(const LAS f32x4*)(b + 256 + 4 * q);
#pragma unroll
                for (int q = 0; q < 8; ++q) { w8[q] = *(const LAS f32x4*)(b + 64 + 4 * q); b8[q] = *(const LAS f32x4*)(b + 320 + 4 * q); k8[q] = *(const LAS f32x4*)(b + 128 + 4 * q); }
                float sp0 = 0.f, sp1 = 0.f, sq0 = 0.f, sq1 = 0.f;
#pragma unroll
                for (int q = 0; q < 8; ++q) { sp0 += P[4 * q] * kk8[q].x; sp1 += P[4 * q + 1] * kk8[q].y; sp0 += P[4 * q + 2] * kk8[q].z; sp1 += P[4 * q + 3] * kk8[q].w;
                    sq0 += Q[4 * q] * kk8[q].x; sq1 += Q[4 * q + 1] * kk8[q].y; sq0 += Q[4 * q + 2] * kk8[q].z; sq1 += Q[4 * q + 3] * kk8[q].w; }
                const float sap = -half_sum(sp0 + sp1), saq = -half_sum(sq0 + sq1);
                f32x4 r8[8];
#pragma unroll
                for (int q = 0; q < 8; ++q) r8[q] = *(const LAS f32x4*)(b + 4 * q);
#pragma unroll
                for (int q = 0; q < 8; ++q)
#pragma unroll
                    for (int e = 0; e < 4; ++e) { P[4 * q + e] = P[4 * q + e] * w8[q][e] + sap * b8[q][e]; Q[4 * q + e] = Q[4 * q + e] * w8[q][e] + (saq * b8[q][e] + vv * k8[q][e]); }
                float pr0 = 0.f, pr1 = 0.f, qr0 = 0.f, qr1 = 0.f;
#pragma unroll
                for (int q = 0; q < 8; ++q) { pr0 += P[4 * q] * r8[q].x; pr1 += P[4 * q + 1] * r8[q].y; pr0 += P[4 * q + 2] * r8[q].z; pr1 += P[4 * q + 3] * r8[q].w;
                    qr0 += Q[4 * q] * r8[q].x; qr1 += Q[4 * q + 1] * r8[q].y; qr0 += Q[4 * q + 2] * r8[q].z; qr1 += Q[4 * q + 3] * r8[q].w; }
                const float prs = half_sum(pr0 + pr1), qrs = half_sum(qr0 + qr1);
                bf16* pq = PRQ + ((size_t)hh * TP + t0 + s) * 128 + row; pq[kh * 64] = (bf16)f2bf(kh ? qrs : prs);
            }
        }
        f32x4* po = (f32x4*)(PP + ((size_t)(c * 8 + hh) * 2) * 4096 + (size_t)row * 64 + 32 * kh); f32x4* qo = po + 1024;
#pragma unroll
        for (int q = 0; q < 8; ++q) { po[q] = (f32x4){P[4 * q], P[4 * q + 1], P[4 * q + 2], P[4 * q + 3]}; qo[q] = (f32x4){Q[4 * q], Q[4 * q + 1], Q[4 * q + 2], Q[4 * q + 3]}; }
    }
}
template <int NRT> __device__ __forceinline__ void chain(const float* phi, size_t mstride, int nsteps, const float* init_src, float* out_each, size_t out_stride, float* fin, LAS float* sb, int tid, int wave, int lane) {
    constexpr int ROWS = NRT == 4 ? 128 : 64;
    const int lr = lane & 15, lq = lane >> 4, jb = wave >> 1, i0 = (wave & 1) * NRT; const bool qpart = (NRT == 2) || (wave & 1);
    for (int u = tid; u < ROWS * 68; u += 512) { const int r = u / 68, cidx = u - r * 68; float v = 0.f;
        if (NRT == 4) v = (r < 64 && cidx == r) ? 1.f : 0.f; else if (init_src && cidx < 64) v = init_src[r * 64 + cidx];
        sb[u] = v; }
    __syncthreads();
    f32x4 bfr[4], acc[NRT];
    { const f32x4* bp = (const f32x4*)(phi + (16 * jb + lr) * 0 + 0); (void)bp; }
#pragma unroll
    for (int q = 0; q < 4; ++q) { f32x4 t4;
#pragma unroll
        for (int e = 0; e < 4; ++e) t4[e] = phi[(16 * lq + 4 * q + e) * 64 + 16 * jb + lr]; bfr[q] = t4; }
#pragma unroll
    for (int ii = 0; ii < NRT; ++ii)
#pragma unroll
        for (int r = 0; r < 4; ++r) acc[ii][r] = qpart ? phi[4096 + (16 * ((i0 + ii) & 3) + 4 * lq + r) * 64 + 16 * jb + lr] : 0.f;
    int cur = 0;
    for (int s = 0; s < nsteps; ++s) {
        f32x4 nb[4], nacc[NRT]; const bool more = (s + 1) < nsteps; const float* np = phi + (size_t)(more ? s + 1 : s) * mstride;
#pragma unroll
        for (int q = 0; q < 4; ++q) { f32x4 t4;
#pragma unroll
            for (int e = 0; e < 4; ++e) t4[e] = np[(16 * lq + 4 * q + e) * 64 + 16 * jb + lr]; nb[q] = t4; }
#pragma unroll
        for (int ii = 0; ii < NRT; ++ii)
#pragma unroll
            for (int r = 0; r < 4; ++r) nacc[ii][r] = (more && qpart) ? np[4096 + (16 * ((i0 + ii) & 3) + 4 * lq + r) * 64 + 16 * jb + lr] : 0.f;
        const LAS float* S = sb + cur * ROWS * 68;
#pragma unroll
        for (int ii = 0; ii < NRT; ++ii) { const LAS f32x4* ap = (const LAS f32x4*)(S + (16 * (i0 + ii) + lr) * 68 + 16 * lq);
#pragma unroll
            for (int q = 0; q < 4; ++q) { const f32x4 a4 = ap[q];
#pragma unroll
                for (int e = 0; e < 4; ++e) acc[ii] = __builtin_amdgcn_mfma_f32_16x16x4f32(a4[e], bfr[q][e], acc[ii], 0, 0, 0); } }
        LAS float* Sn = sb + (cur ^ 1) * ROWS * 68;
#pragma unroll
        for (int ii = 0; ii < NRT; ++ii)
#pragma unroll
            for (int r = 0; r < 4; ++r) { const int row = 16 * (i0 + ii) + 4 * lq + r, col = 16 * jb + lr; Sn[row * 68 + col] = acc[ii][r];
                if (NRT == 2) out_each[(size_t)s * out_stride + row * 64 + col] = acc[ii][r];
                else if (!more) fin[row * 64 + col] = acc[ii][r]; }
        __syncthreads(); cur ^= 1;
#pragma unroll
        for (int q = 0; q < 4; ++q) bfr[q] = nb[q];
#pragma unroll
        for (int ii = 0; ii < NRT; ++ii) acc[ii] = nacc[ii];
    }
}
__device__ __forceinline__ void scan_out(const bf16* REC, const float* PP, const bf16* PRQ, const float* BON, const float* ln_w, const float* ln_b, bf16* OZ, int vcu, int G, int wave, int lane) {
    const int lr = lane & 15, lq = lane >> 4;
    for (int task = vcu; task < NCH * 8; task += G) {
        const int c = task >> 3, hh = task & 7, t0 = c * CHT + 16 * wave;
        f32x4 acc[4];
#pragma unroll
        for (int nt = 0; nt < 4; ++nt)
#pragma unroll
            for (int r = 0; r < 4; ++r) acc[nt][r] = bf2f(PRQ[((size_t)hh * TP + t0 + 4 * lq + r) * 128 + 64 + 16 * nt + lr]);
        if (c > 0) { const float* S0 = PP + ((size_t)((c - 1) * 8 + hh) * 2 + 1) * 4096; const bf16* pr = PRQ + ((size_t)hh * TP + t0 + lr) * 128 + 16 * lq;
            float av[16]; { float f0[8], f1[8]; unpack8(*(const v4u*)pr, f0); unpack8(*(const v4u*)(pr + 8), f1);
#pragma unroll
                for (int e = 0; e < 8; ++e) { av[e] = f0[e]; av[8 + e] = f1[e]; } }
#pragma unroll
            for (int nt = 0; nt < 4; ++nt) { const f32x4* sp = (const f32x4*)(S0 + (16 * nt + lr) * 64 + 16 * lq); const f32x4 b0 = sp[0], b1 = sp[1], b2 = sp[2], b3 = sp[3];
                const float bv[16] = {b0.x, b0.y, b0.z, b0.w, b1.x, b1.y, b1.z, b1.w, b2.x, b2.y, b2.z, b2.w, b3.x, b3.y, b3.z, b3.w};
#pragma unroll
                for (int kk = 0; kk < 16; ++kk) acc[nt] = __builtin_amdgcn_mfma_f32_16x16x4f32(av[kk], bv[kk], acc[nt], 0, 0, 0); } }
#pragma unroll
        for (int r = 0; r < 4; ++r) { const int t = t0 + 4 * lq + r;
            float s = (acc[0][r] + acc[1][r]) + (acc[2][r] + acc[3][r]); s += __shfl_xor(s, 1); s += __shfl_xor(s, 2); s += __shfl_xor(s, 4); s += __shfl_xor(s, 8);
            const float mean = s * (1.f / 64.f); float d[4], q = 0.f;
#pragma unroll
            for (int nt = 0; nt < 4; ++nt) { d[nt] = acc[nt][r] - mean; q += d[nt] * d[nt]; }
            q += __shfl_xor(q, 1); q += __shfl_xor(q, 2); q += __shfl_xor(q, 4); q += __shfl_xor(q, 8);
            const float rs = 1.0f / sqrtf(q * (1.f / 64.f) + 64e-5f);
            if (t < L) { const float bon = BON[hh * TP + t]; const bf16* rec = REC + ((size_t)hh * TP + t) * 448;
#pragma unroll
                for (int nt = 0; nt < 4; ++nt) { const int v = 16 * nt + lr, cc = hh * 64 + v;
                    const float y = d[nt] * rs * ln_w[cc] + ln_b[cc];
                    OZ[(size_t)t * 1024 + cc] = (bf16)f2bf((y + bon * bf2f(rec[192 + v])) * bf2f(rec[384 + v])); } }
        }
    }
}
__device__ __forceinline__ void zero_pad_rows(bf16* Qb, bf16* Kb, bf16* Vb, int gtid, int NTHR) {
    const v4u z = {0u, 0u, 0u, 0u};
    for (int idx = gtid; idx < (LP - L) * 128; idx += NTHR) { const size_t off = (size_t)L * 1024 + (size_t)idx * 8; *(v4u*)(Qb + off) = z; *(v4u*)(Kb + off) = z; *(v4u*)(Vb + off) = z; }
}
__device__ __forceinline__ void combine_rows(const bf16* O0, const bf16* O1, const float* lamv, const float* subw, float lam_init, bf16* OZ, int gw, int NGW, int lane) {
    const float d01 = wave_sum(lamv[lane] * lamv[64 + lane]), d23 = wave_sum(lamv[128 + lane] * lamv[192 + lane]);
    const float lam = __expf(d01) - __expf(d23) + lam_init; const float post = 1.f - lam_init;
    float sw[16];
#pragma unroll
    for (int k = 0; k < 16; ++k) sw[k] = subw[((lane & 7) * 16) + k] * post;
    for (int t = gw; t < L; t += NGW) {
        const v4u* p0 = (const v4u*)(O0 + (size_t)t * 1024 + lane * 16); const v4u* p1 = (const v4u*)(O1 + (size_t)t * 1024 + lane * 16);
        float o[16]; float ss = 0.f;
#pragma unroll
        for (int h2 = 0; h2 < 2; ++h2) { const v4u a = p0[h2], b = p1[h2];
            const unsigned aw[4] = {a.x, a.y, a.z, a.w}, bw[4] = {b.x, b.y, b.z, b.w};
#pragma unroll
            for (int e = 0; e < 4; ++e) { o[h2 * 8 + 2 * e] = bflo(aw[e]) - lam * bflo(bw[e]); o[h2 * 8 + 2 * e + 1] = bfhi(aw[e]) - lam * bfhi(bw[e]); } }
#pragma unroll
        for (int k = 0; k < 16; ++k) ss += o[k] * o[k];
        ss += __shfl_xor(ss, 1); ss += __shfl_xor(ss, 2); ss += __shfl_xor(ss, 4);
        const float rs = 1.0f / sqrtf(ss * (1.f / 128.f) + 1e-5f);
        v4u w0, w1;
        w0.x = pk2(o[0] * rs * sw[0], o[1] * rs * sw[1]); w0.y = pk2(o[2] * rs * sw[2], o[3] * rs * sw[3]); w0.z = pk2(o[4] * rs * sw[4], o[5] * rs * sw[5]); w0.w = pk2(o[6] * rs * sw[6], o[7] * rs * sw[7]);
        w1.x = pk2(o[8] * rs * sw[8], o[9] * rs * sw[9]); w1.y = pk2(o[10] * rs * sw[10], o[11] * rs * sw[11]); w1.z = pk2(o[12] * rs * sw[12], o[13] * rs * sw[13]); w1.w = pk2(o[14] * rs * sw[14], o[15] * rs * sw[15]);
        v4u* po = (v4u*)(OZ + (size_t)t * 1024 + lane * 16); po[0] = w0; po[1] = w1;
    }
}
#define RLX_AGENT __ATOMIC_RELAXED, __HIP_MEMORY_SCOPE_AGENT
#define LDS_WAIT() asm volatile("s_waitcnt lgkmcnt(0)" ::: "memory")
#define VM_WAIT() asm volatile("s_waitcnt vmcnt(0)" ::: "memory")
__device__ __forceinline__ unsigned long long rt() { return __builtin_amdgcn_s_memrealtime(); }

#define XB_TMO      128
#define XB_XCNT(j)  (256  + 64 * (j))
#define XB_XSUB(j)  (1280 + 64 * (j))
#define XB_XGEN(j)  (2304 + 64 * (j))
#define XB_TOP      3328
#define XB_TOPGEN   3392
#define XCD_BAR_WORDS 3456
#define XB_SPIN_CAP (1u << 18)

__device__ __forceinline__ unsigned xb_ld(unsigned* p)              { return __hip_atomic_load(p, __ATOMIC_RELAXED, __HIP_MEMORY_SCOPE_AGENT); }
__device__ __forceinline__ unsigned xb_add(unsigned* p, unsigned v) { return __hip_atomic_fetch_add(p, v, __ATOMIC_RELAXED, __HIP_MEMORY_SCOPE_AGENT); }
__device__ __forceinline__ unsigned xb_xcc_id() { return (unsigned)__builtin_amdgcn_s_getreg((3 << 11) | 20) & 0xFu; }
#define XB_SPIN(cond, bar) do { unsigned _sp = 0; while (cond) { __builtin_amdgcn_s_sleep(1); \
    if ((++_sp & 255u) == 0u) { if (xb_ld(&(bar)[XB_TMO])) break; if (_sp > XB_SPIN_CAP) { atomicAdd(&(bar)[XB_TMO], 1u); break; } } } } while (0)

struct XcdBarrier {
    unsigned* bar; unsigned x;
    volatile LAS unsigned* st;
};

__device__ __forceinline__ XcdBarrier xcd_barrier_post(unsigned* bar, volatile LAS unsigned* st) {
    XcdBarrier b; b.bar = bar; b.x = xb_xcc_id(); b.st = st;
    if (threadIdx.x == 0) (void)xb_add(&bar[XB_XCNT(b.x)], 1u);
    return b;
}
__device__ __forceinline__ void xcd_barrier_complete(unsigned* bar, unsigned x, unsigned& nloc, unsigned& nx) {
    const unsigned G = gridDim.x * gridDim.y * gridDim.z;
    unsigned sum, cnt, mine, sp = 0u;
    for (;;) {
        sum = 0u; cnt = 0u; mine = 0u;
#pragma unroll
        for (unsigned j = 0; j < 16; ++j) { const unsigned c = xb_ld(&bar[XB_XCNT(j)]); sum += c; cnt += (c > 0u) ? 1u : 0u; mine = (j == x) ? c : mine; }
        if (sum == G) break;
        __builtin_amdgcn_s_sleep(1);
        if ((++sp & 255u) == 0u) { if (xb_ld(&bar[XB_TMO])) break; if (sp > XB_SPIN_CAP) { atomicAdd(&bar[XB_TMO], 1u); break; } }
    }
    nloc = mine > 0u ? mine : 1u; nx = cnt > 0u ? cnt : 1u;
}

__device__ __forceinline__ void xcd_barrier(const XcdBarrier& b) {
    asm volatile("s_waitcnt vmcnt(0)" ::: "memory");
    __syncthreads();
    if (threadIdx.x == 0) {
        unsigned* bar = b.bar;
        __builtin_amdgcn_s_waitcnt(0);
        unsigned nloc = b.st[0], nx = b.st[1];
        if (nloc == 0u) { xcd_barrier_complete(bar, b.x, nloc, nx); b.st[0] = nloc; b.st[1] = nx; }
        const unsigned old = xb_add(&bar[XB_XSUB(b.x)], 1u);
        const unsigned gen = old / nloc;
        if (old + 1u == (gen + 1u) * nloc) {
            __builtin_amdgcn_fence(__ATOMIC_RELEASE, "agent");
            asm volatile("s_waitcnt vmcnt(0)" ::: "memory");
            const unsigned og = xb_add(&bar[XB_TOP], 1u);
            const unsigned tg = og / nx;
            if (og + 1u == (tg + 1u) * nx) xb_add(&bar[XB_TOPGEN], 1u);
            else XB_SPIN(xb_ld(&bar[XB_TOPGEN]) == tg, bar);
            __builtin_amdgcn_fence(__ATOMIC_ACQUIRE, "agent");
            xb_add(&bar[XB_XGEN(b.x)], 1u);
            asm volatile("s_waitcnt vmcnt(0)" ::: "memory");
        } else {
            XB_SPIN(xb_ld(&bar[XB_XGEN(b.x)]) == gen, bar);
            __builtin_amdgcn_fence(__ATOMIC_ACQUIRE, "agent");
            asm volatile("s_waitcnt vmcnt(0)" ::: "memory");
        }
    }
    __syncthreads();
}
#define INP(i) inp_ptr(a, (i))
__global__ void __launch_bounds__(NWAVES * 64, 2) mega_fwd(Args a) {
    extern __shared__ __attribute__((aligned(16))) unsigned char lds[];
    cg::grid_group grid = cg::this_grid();
    LAS unsigned char* ldsl = (LAS unsigned char*)lds;
    const int wave0 = __builtin_amdgcn_readfirstlane(threadIdx.x >> 6);
    volatile LAS unsigned* MISC = (volatile LAS unsigned*)(ldsl + 143360);
    if (threadIdx.x < 16) MISC[threadIdx.x] = 0u;
    __syncthreads();
    XcdBarrier xbar = xcd_barrier_post((unsigned*)a.ws, MISC + 8);
#pragma unroll 1
    for (int pp = a.ph_lo * 2; pp < a.ph_hi * 2; ++pp) {
        const int p = pp >> 1, rep = pp & 1;
        unsigned zs = 0u; asm volatile("" : "+s"(zs));
        const int tid = wave0 * 64 + (int)__builtin_amdgcn_mbcnt_hi(~0u, __builtin_amdgcn_mbcnt_lo(~0u, zs));
        int G = gridDim.x, bx = blockIdx.x; asm volatile("" : "+s"(G), "+s"(bx));
        unsigned char* ws = a.ws; asm volatile("" : "+s"(ws));
        const int wave = wave0;
        const int vcu = (G % 8 == 0) ? (bx % 8) * (G / 8) + bx / 8 : bx;
        const int gw = vcu * NWAVES + wave, NGW = G * NWAVES, NTHR = G * NWAVES * 64;
        LAS float* wl = (LAS float*)(ldsl + wave * 16384);
        bf16* XN = (bf16*)(ws + WS_XN);
        int layer, step;
        if (p < 14) { layer = 0; step = p; } else if (p < 22) { layer = 1; step = p - 14; } else if (p < 36) { layer = 2; step = p - 22; } else if (p < 44) { layer = 3; step = p - 36; } else { layer = 4; step = 0; }
        const bool odd = layer & 1; const int j = layer >> 1;
        const float* ng = INP(2) + (size_t)layer * 4096;
        int kind;
        if (layer == 4) kind = 0;
        else if (!odd) kind = (step == 0 || step == 11) ? 0 : (step == 2) ? 2 : (step == 4) ? 3 : (step == 5) ? 4 : (step == 6) ? 10 : (step == 7) ? 5 : (step == 8) ? 11 : (step == 9) ? 6 : 1;
        else kind = (step == 0 || step == 5) ? 0 : (step == 2) ? 8 : (step == 3) ? 9 : 1;
        if (rep == 1 && !((REP_MASK >> kind) & 1)) continue;
        if (kind == 8) {
            const attn_body::bf16* Qb = (const attn_body::bf16*)(ws + WS_Q); const attn_body::bf16* Kb = (const attn_body::bf16*)(ws + WS_K); const attn_body::bf16* Vb = (const attn_body::bf16*)(ws + WS_V);
            attn_body::bf16* Ob0 = (attn_body::bf16*)(ws + WS_O0); attn_body::bf16* Ob1 = (attn_body::bf16*)(ws + WS_O1);
            const int cpx = G >> 3, xg = vcu / cpx, jx = vcu - xg * cpx;
            for (int r = 0;; ++r) {
                const int ps = r * cpx + ((r & 1) ? (cpx - 1 - jx) : jx); if (ps >= 65 * 2) break;
                const int qb = 64 - (ps >> 1), hh = xg, cc = ps & 1;
                int tid_u = tid; asm volatile("" : "+v"(tid_u));
                attn_body::attn_unit<8>(qb, Qb + hh * 128 + cc * 64, Kb + hh * 128 + cc * 64, Vb + hh * 128, (cc ? Ob1 : Ob0) + hh * 128, (char*)lds, tid_u);
            }
        } else {
        int tid_e = tid; asm volatile("" : "+v"(tid_e));
        const int lane = tid_e & 63, gtid = bx * (NWAVES * 64) + tid_e;
        if (kind == 0) {
            if (layer == 4) norm_rows(2, nullptr, nullptr, a.out, (float*)(ws + WS_HM), (const bf16*)(ws + WS_F), ng - 1024, nullptr, XN, gw, NGW, lane);
            else if (step == 0) {
#pragma unroll 1
                for (int ps_ = 0; ps_ < 2; ++ps_) {
                    if ((ps_ ^ (wave & 1)) == 0) wconv(a, layer, wl, gw, NGW, lane, gtid, NTHR);
                    else norm_rows(layer == 0 ? 0 : 1, INP(0), INP(1), a.out, (float*)(ws + WS_HM), (const bf16*)(ws + WS_F), ng - 1024, ng, XN, gw, NGW, lane);
                }
            } else norm_rows(layer == 0 ? 3 : 1, INP(0), INP(1), a.out, (float*)(ws + WS_HM), (const bf16*)(ws + (odd ? WS_M1O : WS_M1E)), ng + 1024, ng + 2048, XN, gw, NGW, lane);
        } else if (kind == 1) {
            int ng_ = 1;
            const bf16* A0 = XN; const bf16* B0 = (const bf16*)(ws + WS_WIN); int N0 = 2304, K0 = 1024, ldc0 = 2304, act0 = 0, sc0 = 0, rope0 = 0; bf16* O0 = (bf16*)(ws + WS_Y); const float* cs0 = nullptr;
            const bf16* A1 = nullptr; const bf16* B1 = nullptr; int N1 = 0, K1 = 0, ldc1 = 0; bf16* O1 = nullptr; const float* cs1 = nullptr;
            if (!odd) {
                if (step == 3) { ng_ = 2; A0 = (const bf16*)(ws + WS_Z); B0 = (const bf16*)(ws + WS_WLR); N0 = 1536; K0 = 256; ldc0 = 1536; O0 = (bf16*)(ws + WS_LR);
                                 A1 = (const bf16*)(ws + WS_DP); B1 = (const bf16*)(ws + WS_WPOOL); N1 = 512; K1 = 512; ldc1 = 1024; O1 = (bf16*)(ws + WS_OZE) + 512; cs1 = INP(18) + (size_t)j * 512; }
                else if (step == 10) { A0 = (const bf16*)(ws + WS_OZE); B0 = (const bf16*)(ws + WS_WOUT); N0 = 1024; ldc0 = 1024; O0 = (bf16*)(ws + WS_M1E); }
            } else {
                if (step == 1) { N0 = 3072; ldc0 = 1024; sc0 = 1024; O0 = (bf16*)(ws + WS_Q); rope0 = 1; }
                else if (step == 4) { A0 = (const bf16*)(ws + WS_OZO); B0 = (const bf16*)(ws + WS_WOUT); N0 = 1024; ldc0 = 1024; O0 = (bf16*)(ws + WS_M1O); }
            }
            const int mstep = odd ? step - 6 : step - 12;
            if (mstep == 0) { B0 = (const bf16*)(ws + WS_W1); N0 = 4096; ldc0 = 4096; act0 = 1; O0 = (bf16*)(ws + WS_HID); }
            else if (mstep == 1) { A0 = (const bf16*)(ws + WS_HID); B0 = (const bf16*)(ws + WS_W2); N0 = 1024; K0 = 4096; ldc0 = 1024; O0 = (bf16*)(ws + WS_F); }
#pragma unroll 1
            for (int q = 0; q < ng_; ++q) {
                const bf16* Aq = q ? A1 : A0; const bf16* Bq = q ? B1 : B0; bf16* Oq = q ? O1 : O0; const int Nq = q ? N1 : N0, Kq = q ? K1 : K0, ldq = q ? ldc1 : ldc0, scq = q ? 0 : sc0, actq = q ? 0 : act0; const float* csq = q ? cs1 : cs0;
                { int tid_t = tid; asm volatile("" : "+v"(tid_t));
                  thin_gemm(Aq, Bq, Nq, Kq, Oq, ldq, csq, scq, ACT_BYTES / 2, actq, q ? 0 : rope0, (LAS float*)ldsl, vcu, G, tid_t, wave, tid_t & 63); }
                pg8::Gemm g{Aq + (size_t)NMETA * Kq, Bq, 16384, Nq, Kq}; pg8::StaticOrder S; S.init(16384, g.N, G, bx);
                pg8::EpiBf16 E{Oq + (size_t)NMETA * ldq, ldq, csq, scq, ACT_BYTES / 2, actq, q ? 0 : rope0, NMETA};
                { unsigned z3 = 0u; asm volatile("" : "+s"(z3)); const int tid_g = wave0 * 64 + (int)__builtin_amdgcn_mbcnt_hi(~0u, __builtin_amdgcn_mbcnt_lo(~0u, z3));
                  pg8::gemm_phase<pg8::EpiBf16, pg8::StaticOrder, true, true>(ldsl, g, S, E, tid_g); }
            }
            if (rope0) { unsigned z2 = 0u; asm volatile("" : "+s"(z2)); const int tid_z = wave0 * 64 + (int)__builtin_amdgcn_mbcnt_hi(~0u, __builtin_amdgcn_mbcnt_lo(~0u, z2));
                zero_pad_rows((bf16*)(ws + WS_Q), (bf16*)(ws + WS_K), (bf16*)(ws + WS_V), bx * (NWAVES * 64) + tid_z, NTHR); }
        } else if (kind == 2) {
            shift_rows((const bf16*)(ws + WS_Y), INP(6) + (size_t)j * 1792, (bf16*)(ws + WS_REC), (bf16*)(ws + WS_Z), (bf16*)(ws + WS_DP), gw, NGW, lane);
        } else if (kind == 3) {
            prep_rows((const bf16*)(ws + WS_LR), (bf16*)(ws + WS_REC), (float*)(ws + WS_BON), INP(7) + j * 512, INP(9) + j * 512, INP(12) + j * 512, INP(13) + j * 512, INP(14) + j * 512, gw, NGW, lane);
        } else if (kind == 4) {
            scan1((const bf16*)(ws + WS_REC), (float*)(ws + WS_PP), (bf16*)(ws + WS_PRQ), wl, gw, NGW, lane);
        } else if (kind == 10) {
            if (vcu >= 128) wconv_mlp(a, layer, 1, wl, (vcu - 128) * NWAVES + wave, (G - 128) * NWAVES, lane);
            if (vcu < 128) { const int g = vcu >> 3, hh = vcu & 7; float* PPf = (float*)(ws + WS_PP);
                chain<4>(PPf + ((size_t)(8 * g * 8 + hh) * 2) * 4096, (size_t)8 * 2 * 4096, 8, nullptr, nullptr, 0, (float*)(ws + WS_GPP) + ((size_t)(g * 8 + hh) * 2) * 4096, (LAS float*)ldsl, tid, wave, lane); }
        } else if (kind == 5) {
            if (vcu >= 8) wconv_mlp(a, layer, 0, wl, (vcu - 8) * NWAVES + wave, (G - 8) * NWAVES, lane);
            if (vcu < 8) { const int hh = vcu; float* PPf = (float*)(ws + WS_PP);
                chain<2>((const float*)(ws + WS_GPP) + ((size_t)hh * 2) * 4096, (size_t)8 * 2 * 4096, 16, nullptr, PPf + ((size_t)(7 * 8 + hh) * 2 + 1) * 4096, (size_t)64 * 2 * 4096, nullptr, (LAS float*)ldsl, tid, wave, lane); }
        } else if (kind == 11) {
            if (vcu >= 128) wconv_mlp(a, layer, 2, wl, (vcu - 128) * NWAVES + wave, (G - 128) * NWAVES, lane);
            if (vcu < 128) { const int g = vcu >> 3, hh = vcu & 7; float* PPf = (float*)(ws + WS_PP);
                chain<2>(PPf + ((size_t)(8 * g * 8 + hh) * 2) * 4096, (size_t)8 * 2 * 4096, 7, g ? PPf + ((size_t)((8 * g - 1) * 8 + hh) * 2 + 1) * 4096 : nullptr, PPf + ((size_t)(8 * g * 8 + hh) * 2 + 1) * 4096, (size_t)8 * 2 * 4096, nullptr, (LAS float*)ldsl, tid, wave, lane); }
        } else if (kind == 6) {
            scan_out((const bf16*)(ws + WS_REC), (const float*)(ws + WS_PP), (const bf16*)(ws + WS_PRQ), (const float*)(ws + WS_BON), INP(15) + j * 512, INP(16) + j * 512, (bf16*)(ws + WS_OZE), vcu, G, wave, lane);
        } else {
            combine_rows((const bf16*)(ws + WS_O0), (const bf16*)(ws + WS_O1), INP(21) + j * 256, INP(22) + j * 128, 0.8f - 0.6f * expf(-0.3f * (float)layer), (bf16*)(ws + WS_OZO), gw, NGW, lane);
        }
        }
        if ((rep == 1 || !((REP_MASK >> kind) & 1)) && p + 1 < a.ph_hi) {
            if (p == a.ph_lo) grid.sync();
            else xcd_barrier(xbar);
        }
    }
}

extern "C" void kernel_launch(void* const* d_in, const int* in_sizes, int n_in, void* d_out, int out_size, void* d_ws, size_t ws_size, hipStream_t stream) {
    static int grid = 0;
    if (grid == 0) {
        if (n_in != 24 || out_size != 16384 * 1024 || ws_size < WS_END) { fprintf(stderr, "kernel_launch: unexpected shapes: n_in %d out %d ws %zu; nothing launched\n", n_in, out_size, ws_size); grid = -1; return; }
        int dev = 0, cus = 0, per_cu = 0;
        if (hipGetDevice(&dev) != hipSuccess || hipDeviceGetAttribute(&cus, hipDeviceAttributeMultiprocessorCount, dev) != hipSuccess) { grid = -1; return; }
        if (hipFuncSetAttribute((const void*)mega_fwd, hipFuncAttributeMaxDynamicSharedMemorySize, LDS_BYTES) != hipSuccess) { fprintf(stderr, "kernel_launch: hipFuncSetAttribute failed\n"); grid = -1; return; }
        if (hipOccupancyMaxActiveBlocksPerMultiprocessor(&per_cu, (const void*)mega_fwd, NWAVES * 64, LDS_BYTES) != hipSuccess || per_cu < 1) { fprintf(stderr, "kernel_launch: occupancy query says %d blocks per CU\n", per_cu); per_cu = 1; }
        (void)hipGetLastError();
        grid = cus;
    }
    if (grid < 0) return;
    if (hipMemsetAsync(d_ws, 0, 16384, stream) != hipSuccess) { fprintf(stderr, "kernel_launch: hipMemsetAsync failed\n"); return; }
    Args a{};
    for (int i = 0; i < 24; ++i) a.in[i] = (const float*)d_in[i];
    a.out = (float*)d_out; a.ws = (unsigned char*)d_ws;
#if MK_SINGLE
    a.ph_lo = 0; a.ph_hi = NPH;
    void* args[] = {&a};
    hipError_t e = hipLaunchCooperativeKernel((const void*)mega_fwd, dim3(grid), dim3(NWAVES * 64), args, LDS_BYTES, stream);
    if (e != hipSuccess) fprintf(stderr, "kernel_launch: cooperative launch failed: %s (grid %d)\n", hipGetErrorString(e), grid);
#else
    for (int p = 0; p < NPH; ++p) { a.ph_lo = p; a.ph_hi = p + 1; hipLaunchKernelGGL(mega_fwd, dim3(grid), dim3(NWAVES * 64), LDS_BYTES, stream, a); }
#endif
}
```

```cpp
#include <hip/hip_runtime.h>
#include <hip/hip_cooperative_groups.h>
#include <cstdio>
#include <cstdint>
namespace cg = cooperative_groups;
#define MK_SINGLE 1
#define REP_MASK 0
#define BAR_TWICE 0
namespace pg8 {
#define PG8_LAS __attribute__((address_space(3)))
typedef unsigned short bf16_t;
typedef short bf16x8 __attribute__((ext_vector_type(8)));
typedef float f32x4 __attribute__((ext_vector_type(4)));
typedef unsigned u32x4 __attribute__((ext_vector_type(4)));
constexpr int BM = 256, BK = 64, HALF = 128, HTB = HALF * BK * 2  , STAGE_BYTES = 8 * HTB, NXCD = 8, WGM = 8;

__host__ __device__ __forceinline__ int lds_byte(int r, int c) { const int st = (r >> 4) * 2 + (c >> 5), rr = r & 15, cc = c & 31, ob = rr * 64 + cc * 2; return st * 1024 + (ob ^ (((ob >> 9) & 1) << 5)); }
__host__ __device__ __forceinline__ void stage_rc(int b, int& R, int& C) { const int st = b / 1024, sb = b % 1024, swz = sb ^ (((sb >> 9) & 1) << 5); R = (st >> 1) * 16 + swz / 64; C = (st & 1) * 32 + (swz % 64) / 2; }
__host__ __device__ __forceinline__ int perm32(int rho) { const int n = rho >> 4, i = rho & 15; return 8 * (i >> 2) + 4 * n + (i & 3); }

struct Unit { int pm, pn; };
struct Gemm { const bf16_t* A; const bf16_t* Bt; int M, N, K; };

struct StaticOrder {
    int nM, nN, nwg, G, c;
    __host__ __device__ void init(int M, int N, int G_, int c_) { nM = M / BM; nN = N / BM; nwg = nM * nN; G = G_; c = c_; }
    __host__ __device__ bool next(int i, Unit& u) const {
        const long L = (long)i * G + c; if (L >= nwg) return false;
        int wgid = (int)L; { const int q = nwg / NXCD, r = nwg % NXCD, xcd = wgid % NXCD, off = wgid / NXCD; wgid = (xcd < r ? xcd * (q + 1) : r * (q + 1) + (xcd - r) * q) + off; }
        const int nig = WGM * nN, gid = wgid / nig, fm = gid * WGM, gsz = (nM - fm) < WGM ? (nM - fm) : WGM;
        u.pm = fm + ((wgid % nig) % gsz); u.pn = (wgid % nig) / gsz; return true;
    }
    __device__ __forceinline__ void a_ready(const Unit&) const {}
    __device__ __forceinline__ void done(const Unit&) const {}
};

__device__ __forceinline__ unsigned cvt_pk_bf16(float lo, float hi) { unsigned r; asm volatile("v_cvt_pk_bf16_f32 %0, %1, %2" : "=v"(r) : "v"(lo), "v"(hi)); return r; }
typedef float f32x2 __attribute__((ext_vector_type(2)));
struct EpiBf16 {
    static constexpr bool PERM = true, AFTER_DRAIN = false;
    bf16_t* O; int ldc; const float* cscale; int split_cols; size_t split_stride; int act; int rope  ; int pos_off;
    __device__ __forceinline__ void operator()(const f32x4 (&acc)[2][2][4][2], const Unit& u, int wr, int wc, int fr, int fq) const {
        const int row0 = u.pm * BM + wr * 64 + fr; int colt = u.pn * BM; bf16_t* base = O;
        int tsel = 0; if (split_cols) { const int t = colt / split_cols; base += (size_t)t * split_stride; colt -= t * split_cols; tsel = t; }
        const bool do_rope = rope && tsel < 2; const float qs = (do_rope && tsel == 0) ? 0.18033688011112042f : 1.f;
        const int col0 = colt + wc * 32 + 8 * fq, ccol0 = u.pn * BM + wc * 32 + 8 * fq;
        const __amdgpu_buffer_rsrc_t orsrc = __builtin_amdgcn_make_buffer_rsrc((void*)base, (short)0, 0x7fffffff, 0x00020000);
        f32x4 sv[2][2];
#pragma unroll
        for (int bj = 0; bj < 2; ++bj)
#pragma unroll
            for (int n = 0; n < 2; ++n) sv[bj][n] = cscale ? *(const f32x4*)(cscale + ccol0 + bj * HALF + 4 * n) : (f32x4){1.f, 1.f, 1.f, 1.f};
#pragma unroll
        for (int ai = 0; ai < 2; ++ai)
#pragma unroll
            for (int m = 0; m < 4; ++m) { const int roff = ((row0 + ai * HALF + m * 16) * ldc + col0) * 2;
#pragma unroll
                for (int bj = 0; bj < 2; ++bj) { f32x4 v0 = acc[ai][bj][m][0], v1 = acc[ai][bj][m][1];
                    if (do_rope) { const float pos = (float)(row0 + ai * HALF + m * 16 + pos_off); const int j0 = ((col0 + bj * HALF) & 63) >> 1;
#pragma unroll
                        for (int e2 = 0; e2 < 4; ++e2) { const float inv = expf(-(float)(j0 + e2) * (9.210340371976184f / 32.f)); const float ang = pos * inv; const double rev = (double)ang * 0.15915494309189535; const float fr_ = (float)(rev - __builtin_rint(rev));
                            const float cs = __builtin_amdgcn_cosf(fr_) * qs, sn = __builtin_amdgcn_sinf(fr_) * qs;
                            if (e2 < 2) { const float x1 = v0[2 * e2], x2 = v0[2 * e2 + 1]; v0[2 * e2] = x1 * cs - x2 * sn; v0[2 * e2 + 1] = x2 * cs + x1 * sn; }
                            else { const float x1 = v1[2 * e2 - 4], x2 = v1[2 * e2 - 3]; v1[2 * e2 - 4] = x1 * cs - x2 * sn; v1[2 * e2 - 3] = x2 * cs + x1 * sn; } } }
                    if (act == 1) {
#pragma unroll
                        for (int e = 0; e < 4; ++e) { const float a = fmaxf(v0[e], 0.f), b = fmaxf(v1[e], 0.f); v0[e] = a * a; v1[e] = b * b; } }
                    v0 = v0 * sv[bj][0]; v1 = v1 * sv[bj][1]; u32x4 w; w.x = cvt_pk_bf16(v0[0], v0[1]); w.y = cvt_pk_bf16(v0[2], v0[3]); w.z = cvt_pk_bf16(v1[0], v1[1]); w.w = cvt_pk_bf16(v1[2], v1[3]);
                    __builtin_amdgcn_raw_buffer_store_b128(w, orsrc, roff + bj * HALF * 2, 0, 16); } }
    }
};
template <class Epi, class Sched, bool ALIGN_EPI = false, bool SP2 = false>
__device__ __forceinline__ void gemm_phase(PG8_LAS unsigned char* lds, const Gemm g, const Sched& S, const Epi& E, const int tid) {
    const int wid = __builtin_amdgcn_readfirstlane(tid >> 6), lane = tid & 63, wr = wid >> 2, wc = wid & 3, fr = lane & 15, fq = lane >> 4;
    const int K = g.K, nt = K / BK;
    unsigned voffA[2], voffB[2];
#pragma unroll
    for (int i = 0; i < 2; ++i) { int R, C; stage_rc(tid * 16 + i * 8192, R, C); const int Rb = Epi::PERM ? ((R & ~31) + perm32(R & 31)) : R;
        voffA[i] = (unsigned)(R * K + C) * 2u; voffB[i] = (unsigned)(Rb * K + C) * 2u; }
    const size_t kstep = (size_t)(BK * 2);
    const size_t hstep = (size_t)HALF * K * 2;
    const size_t tstep = 2 * hstep;
    const unsigned ldsw = (unsigned)wid * 1024u;
    const int aoff = lds_byte(wr * 64 + fr, fq * 8), boff = lds_byte(wc * 32 + fr, fq * 8);
#define PG8_SA(b, h) (((b) * 2 + (h)) * HTB)
#define PG8_SB(b, h) ((4 + (b) * 2 + (h)) * HTB)
#define PG8_STAGE(bufoff, gbase, voff) do { _Pragma("unroll") for (int _i = 0; _i < 2; ++_i) \
        __builtin_amdgcn_global_load_lds((const unsigned*)((const char*)(gbase) + (voff)[_i]), (PG8_LAS unsigned*)(lds + (bufoff) + ldsw + _i * 8192), 16, 0, 0); } while (0)
#define PG8_LDA(dst, b, h) do { _Pragma("unroll") for (int m = 0; m < 4; ++m) _Pragma("unroll") for (int k = 0; k < 2; ++k) dst[m][k] = *(const PG8_LAS bf16x8*)(lds + PG8_SA(b, h) + aoff + m * 2048 + k * 1024); } while (0)
#define PG8_LDB(dst, b, h) do { _Pragma("unroll") for (int n = 0; n < 2; ++n) _Pragma("unroll") for (int k = 0; k < 2; ++k) dst[n][k] = *(const PG8_LAS bf16x8*)(lds + PG8_SB(b, h) + boff + n * 2048 + k * 1024); } while (0)
#define PG8_MMA(ai, bj, At, Bt) do { __builtin_amdgcn_s_setprio(1); _Pragma("unroll") for (int m = 0; m < 4; ++m) _Pragma("unroll") for (int n = 0; n < 2; ++n) _Pragma("unroll") for (int k = 0; k < 2; ++k) \
        acc[ai][bj][m][n] = __builtin_amdgcn_mfma_f32_16x16x32_bf16(Bt[n][k], At[m][k], acc[ai][bj][m][n], 0, 0, 0); __builtin_amdgcn_s_setprio(0); } while (0)
#define PG8_WAIT_V(n) asm volatile("s_waitcnt vmcnt(" #n ")" ::: "memory")
#define PG8_WAIT_L(n) asm volatile("s_waitcnt lgkmcnt(" #n ")" ::: "memory")
#define PG8_BAR __builtin_amdgcn_s_barrier()
#define PG8_SCHED __builtin_amdgcn_sched_barrier(0)
    Unit cur, nxt; int ui = 0;
    if (!S.next(0, cur)) return;
    f32x4 acc[2][2][4][2];
#pragma unroll
    for (int a = 0; a < 2; ++a)
#pragma unroll
        for (int b = 0; b < 2; ++b)
#pragma unroll
            for (int m = 0; m < 4; ++m)
#pragma unroll
                for (int n = 0; n < 2; ++n) acc[a][b][m][n] = (f32x4){0.f, 0.f, 0.f, 0.f};
    bf16x8 At[4][2], B0[2][2], B1[2][2];
    const char* cA = (const char*)g.A + (size_t)cur.pm * tstep; const char* cB = (const char*)g.Bt + (size_t)cur.pn * tstep;
    S.a_ready(cur);
    if constexpr (SP2) {
        PG8_STAGE(PG8_SB(0, 0), cB, voffB); PG8_STAGE(PG8_SB(0, 1), cB + hstep, voffB); PG8_STAGE(PG8_SA(0, 0), cA, voffA); PG8_STAGE(PG8_SA(0, 1), cA + hstep, voffA);
        if (wr == 1) PG8_BAR;
        PG8_WAIT_V(2); PG8_BAR;
        PG8_STAGE(PG8_SB(1, 0), cB + kstep, voffB); PG8_STAGE(PG8_SA(1, 0), cA + kstep, voffA); PG8_STAGE(PG8_SB(1, 1), cB + hstep + kstep, voffB);
        PG8_WAIT_V(6); PG8_BAR;
    } else {
        PG8_STAGE(PG8_SB(0, 0), cB, voffB); PG8_STAGE(PG8_SA(0, 0), cA, voffA); PG8_STAGE(PG8_SB(0, 1), cB + hstep, voffB); PG8_STAGE(PG8_SA(0, 1), cA + hstep, voffA);
        if (wr == 1) PG8_BAR;
        PG8_WAIT_V(4); PG8_BAR;
        PG8_STAGE(PG8_SB(1, 0), cB + kstep, voffB); PG8_STAGE(PG8_SA(1, 0), cA + kstep, voffA); PG8_STAGE(PG8_SB(1, 1), cB + hstep + kstep, voffB);
        PG8_WAIT_V(6); PG8_BAR;
    }
    for (;;) {
        const bool has_next = S.next(ui + 1, nxt);
        const char* nA = has_next ? (const char*)g.A + (size_t)nxt.pm * tstep : cA; const char* nB = has_next ? (const char*)g.Bt + (size_t)nxt.pn * tstep : cB;
        for (int t = 0; t < nt; t += 2) {
            const bool last = (t == nt - 2);
            const char* a1 = cA + (size_t)(t + 1) * kstep;
            const char* a2 = last ? nA : cA + (size_t)(t + 2) * kstep; const char* b2 = last ? nB : cB + (size_t)(t + 2) * kstep;
            const char* a3 = a2 + kstep; const char* b3 = b2 + kstep;
            if (last && has_next) S.a_ready(nxt);
            if constexpr (SP2) {
            PG8_LDB(B0, 0, 0); PG8_LDB(B1, 0, 1); PG8_SCHED; PG8_LDA(At, 0, 0); PG8_STAGE(PG8_SA(1, 1), a1 + hstep, voffA);
            PG8_WAIT_V(8); PG8_WAIT_L(0); PG8_BAR; PG8_MMA(0, 0, At, B0); PG8_MMA(0, 1, At, B1); PG8_BAR; PG8_SCHED;
            PG8_LDA(At, 0, 1); PG8_STAGE(PG8_SB(0, 0), b2, voffB); PG8_STAGE(PG8_SB(0, 1), b2 + hstep, voffB); PG8_STAGE(PG8_SA(0, 0), a2, voffA);
            PG8_WAIT_V(8); PG8_WAIT_L(0); PG8_BAR; PG8_MMA(1, 0, At, B0); PG8_MMA(1, 1, At, B1); PG8_BAR; PG8_SCHED;
            PG8_LDB(B0, 1, 0); PG8_LDB(B1, 1, 1); PG8_SCHED; PG8_LDA(At, 1, 0); PG8_STAGE(PG8_SA(0, 1), a2 + hstep, voffA);
            PG8_WAIT_V(8); PG8_WAIT_L(0); PG8_BAR; PG8_MMA(0, 0, At, B0); PG8_MMA(0, 1, At, B1); PG8_BAR; PG8_SCHED;
            PG8_LDA(At, 1, 1); PG8_STAGE(PG8_SB(1, 0), b3, voffB); PG8_STAGE(PG8_SB(1, 1), b3 + hstep, voffB); PG8_STAGE(PG8_SA(1, 0), a3, voffA);
            PG8_WAIT_V(8); PG8_WAIT_L(0); PG8_BAR; PG8_MMA(1, 0, At, B0); PG8_MMA(1, 1, At, B1); PG8_BAR; PG8_SCHED;
            } else {
            PG8_LDB(B0, 0, 0); PG8_SCHED; PG8_LDA(At, 0, 0); PG8_STAGE(PG8_SA(1, 1), a1 + hstep, voffA);
            PG8_WAIT_L(8); PG8_BAR; PG8_WAIT_L(0); PG8_MMA(0, 0, At, B0); PG8_BAR; PG8_SCHED;
            PG8_LDB(B1, 0, 1); PG8_STAGE(PG8_SB(0, 0), b2, voffB);
            PG8_BAR; PG8_WAIT_L(0); PG8_MMA(0, 1, At, B1); PG8_BAR;
            PG8_LDA(At, 0, 1); PG8_STAGE(PG8_SA(0, 0), a2, voffA);
            PG8_BAR; PG8_WAIT_L(0); PG8_MMA(1, 0, At, B0); PG8_BAR; PG8_SCHED;
            PG8_STAGE(PG8_SB(0, 1), b2 + hstep, voffB);
            PG8_WAIT_V(6); PG8_BAR; PG8_MMA(1, 1, At, B1); PG8_BAR;
            PG8_LDB(B0, 1, 0); PG8_SCHED; PG8_LDA(At, 1, 0); PG8_STAGE(PG8_SA(0, 1), a2 + hstep, voffA);
            PG8_WAIT_L(8); PG8_BAR; PG8_WAIT_L(0); PG8_MMA(0, 0, At, B0); PG8_BAR; PG8_SCHED;
            PG8_LDB(B1, 1, 1); PG8_STAGE(PG8_SB(1, 0), b3, voffB);
            PG8_BAR; PG8_WAIT_L(0); PG8_MMA(0, 1, At, B1); PG8_BAR;
            PG8_LDA(At, 1, 1); PG8_STAGE(PG8_SA(1, 0), a3, voffA);
            PG8_BAR; PG8_WAIT_L(0); PG8_MMA(1, 0, At, B0); PG8_BAR; PG8_SCHED;
            PG8_STAGE(PG8_SB(1, 1), b3 + hstep, voffB);
            PG8_WAIT_V(6); PG8_BAR; PG8_MMA(1, 1, At, B1); PG8_BAR;
            }
        }
        if constexpr (ALIGN_EPI) { if (wr == 0) PG8_BAR; }
        if constexpr (!Epi::AFTER_DRAIN) { E(acc, cur, wr, wc, fr, fq); S.done(cur); }
        if (!has_next) break;
#pragma unroll
        for (int a = 0; a < 2; ++a)
#pragma unroll
            for (int b = 0; b < 2; ++b)
#pragma unroll
                for (int m = 0; m < 4; ++m)
#pragma unroll
                    for (int n = 0; n < 2; ++n) acc[a][b][m][n] = (f32x4){0.f, 0.f, 0.f, 0.f};
        cur = nxt; cA = nA; cB = nB; ++ui;
        if constexpr (ALIGN_EPI) { if (wr == 1) PG8_BAR; }
    }
    PG8_WAIT_V(0);
    if constexpr (!ALIGN_EPI) { if (wr == 0) PG8_BAR; }
    PG8_BAR;
    if constexpr (Epi::AFTER_DRAIN) { E.fused(acc, cur, wr, wc, fr, fq, lds, wid, lane); S.done(cur); }
#undef PG8_SA
#undef PG8_SB
#undef PG8_STAGE
#undef PG8_LDA
#undef PG8_LDB
#undef PG8_MMA
#undef PG8_WAIT_V
#undef PG8_WAIT_L
#undef PG8_BAR
#undef PG8_SCHED
}
}
#define ATTN_STORE16(p,v) asm volatile("global_store_dwordx4 %0, %1, off sc1\n\ts_nop 1" :: "v"(p), "v"(v) : "memory")
#include <hip/hip_bf16.h>
#include <cmath>
namespace attn_body {
using bf16=__hip_bfloat16;
using bf16x8=__attribute__((ext_vector_type(8)))short;
using s16x4=__attribute__((ext_vector_type(4)))short;
using f32x16=__attribute__((ext_vector_type(16)))float;
using u32x4=__attribute__((ext_vector_type(4)))unsigned;
typedef float f32x4_t __attribute__((ext_vector_type(4)));
constexpr int D=64,DM=1024;
constexpr int NW=8,QBLK=32,QB=QBLK*NW,KVBLK=64;
constexpr int ATTN_PITCH=DM, ATTN_UNIT_ROWS=QB;
__device__ __forceinline__ int crow(int r,int hi){return (r&3)+8*(r>>2)+4*hi;}
#define SBAR() __builtin_amdgcn_sched_barrier(0)
__device__ __forceinline__ void cmask(f32x16&p0,f32x16&p1,int jb,int qrel,int hi){
  const float NEG=-INFINITY; int kb=64*jb+4*hi;
  #pragma unroll
  for(int r=0;r<16;++r){int kv=kb+(r&3)+8*(r>>2); if(kv>qrel)p0[r]=NEG; if(kv+32>qrel)p1[r]=NEG;}
}

constexpr int NSLOT=3, SLOTB=8192;
constexpr int LDS_K=0, LDS_V=NSLOT*SLOTB, LDS_V1=2*NSLOT*SLOTB, LDS_WS=3*NSLOT*SLOTB, LDS_QS=LDS_WS+NW*64*4, LDS_OST=LDS_V, LDS_BYTES=LDS_QS+NW*4096;
constexpr float C2=0.125f*1.4426950408889634f;
__device__ __forceinline__ void glds16(const void*gsrc,unsigned lds_dst){unsigned keep;
  asm volatile("s_mov_b32 %0, m0\n\ts_mov_b32 m0, %2\n\ts_nop 0\n\tglobal_load_lds_dwordx4 %1, off\n\ts_mov_b32 m0, %0":"=&s"(keep):"v"(gsrc),"s"(lds_dst):"memory");}
__device__ __forceinline__ float max3f(float a,float b,float c){float r;asm("v_max3_f32 %0, %1, %2, %3":"=v"(r):"v"(a),"v"(b),"v"(c));return r;}
__device__ __forceinline__ float max2f(float a,float b){float r;asm("v_max_f32_e32 %0, %1, %2":"=v"(r):"v"(a),"v"(b));return r;}
__device__ __forceinline__ float fadd_s(float a,float b){float r;asm("v_add_f32_e32 %0, %1, %2":"=v"(r):"v"(a),"v"(b));return r;}
__device__ __forceinline__ float fsub_s(float a,float b){float r;asm("v_sub_f32_e32 %0, %1, %2":"=v"(r):"v"(a),"v"(b));return r;}
typedef float f32x2_t __attribute__((ext_vector_type(2))); typedef __bf16 bf16x2_t __attribute__((ext_vector_type(2)));
__device__ __forceinline__ unsigned cvtpk_s(float lo,float hi){f32x2_t v={lo,hi};bf16x2_t b=__builtin_convertvector(v,bf16x2_t);return __builtin_bit_cast(unsigned,b);}
#define WAIT_BAR(N) asm volatile("s_waitcnt vmcnt(" #N ") lgkmcnt(0)\n\ts_barrier":::"memory")

__device__ __forceinline__ void qkt(f32x16&p0,f32x16&p1,const char*Kslot,const bf16x8*qr,const f32x16&negm,int r32,int hi){
  const char*kb=Kslot+hi*1024+r32*16;
  #pragma unroll
  for(int d0=0;d0<4;++d0){
    const bf16x8 b0=*reinterpret_cast<const bf16x8*>(kb+d0*2048);
    const bf16x8 b1=*reinterpret_cast<const bf16x8*>(kb+d0*2048+512);
    if(d0==0){p0=__builtin_amdgcn_mfma_f32_32x32x16_bf16(b0,qr[0],negm,0,0,0);p1=__builtin_amdgcn_mfma_f32_32x32x16_bf16(b1,qr[0],negm,0,0,0);}
    else{p0=__builtin_amdgcn_mfma_f32_32x32x16_bf16(b0,qr[d0],p0,0,0,0);p1=__builtin_amdgcn_mfma_f32_32x32x16_bf16(b1,qr[d0],p1,0,0,0);}}
}
typedef __attribute__((address_space(3))) const char* lds_cptr;
typedef short v4i16_t __attribute__((ext_vector_type(4)));
__device__ __forceinline__ void kload8(bf16x8*kf,lds_cptr kp){
  kf[0]=*(const __attribute__((address_space(3))) bf16x8*)(kp);      kf[1]=*(const __attribute__((address_space(3))) bf16x8*)(kp+512);
  kf[2]=*(const __attribute__((address_space(3))) bf16x8*)(kp+2048); kf[3]=*(const __attribute__((address_space(3))) bf16x8*)(kp+2560);
  kf[4]=*(const __attribute__((address_space(3))) bf16x8*)(kp+4096); kf[5]=*(const __attribute__((address_space(3))) bf16x8*)(kp+4608);
  kf[6]=*(const __attribute__((address_space(3))) bf16x8*)(kp+6144); kf[7]=*(const __attribute__((address_space(3))) bf16x8*)(kp+6656);
}
__device__ __forceinline__ void kload2(bf16x8*kf,lds_cptr kp,int j){ kf[2*j]=*(const __attribute__((address_space(3))) bf16x8*)(kp+j*2048); kf[2*j+1]=*(const __attribute__((address_space(3))) bf16x8*)(kp+j*2048+512); }
__device__ __forceinline__ s16x4 vtr(lds_cptr p){ return __builtin_bit_cast(s16x4,__builtin_amdgcn_ds_read_tr16_b64_v4i16((__attribute__((address_space(3))) v4i16_t*)p)); }
__device__ __forceinline__ float rowmax(const f32x16&p0,const f32x16&p1){
  float a=max3f(p0[0],p0[1],p1[0]),b=max3f(p0[2],p0[3],p1[1]);a=max3f(a,p1[2],p1[3]);
  #pragma unroll
  for(int r=4;r<16;r+=4){a=max3f(a,p0[r],p0[r+1]);b=max3f(b,p0[r+2],p0[r+3]);a=max3f(a,p1[r],p1[r+1]);b=max3f(b,p1[r+2],p1[r+3]);}
  const float m=max2f(a,b);
  auto rr=__builtin_amdgcn_permlane32_swap(__float_as_uint(m),__float_as_uint(m),false,false);
  return max2f(__uint_as_float(rr[0]),__uint_as_float(rr[1]));
}
__device__ __forceinline__ void pv(f32x16*o,int vb,bf16x8 pa0,bf16x8 pa1,bf16x8 pa2,bf16x8 pa3){
  #pragma unroll
  for(int d0=0;d0<2;++d0){s16x4 lo[4],hi[4];
    #pragma unroll
    for(int ks=0;ks<4;++ks){
      asm volatile("ds_read_b64_tr_b16 %0,%1 offset:%c2":"=&v"(lo[ks]):"v"(vb),"i"(d0*4096+ks*1024):"memory");
      asm volatile("ds_read_b64_tr_b16 %0,%1 offset:%c2":"=&v"(hi[ks]):"v"(vb),"i"(d0*4096+ks*1024+512):"memory");}
    asm volatile("s_waitcnt lgkmcnt(0)":::"memory");SBAR();
    #define PK(k) (bf16x8){lo[k][0],lo[k][1],lo[k][2],lo[k][3],hi[k][0],hi[k][1],hi[k][2],hi[k][3]}
    o[d0]=__builtin_amdgcn_mfma_f32_32x32x16_bf16(pa0,PK(0),o[d0],0,0,0);
    o[d0]=__builtin_amdgcn_mfma_f32_32x32x16_bf16(pa1,PK(1),o[d0],0,0,0);
    o[d0]=__builtin_amdgcn_mfma_f32_32x32x16_bf16(pa2,PK(2),o[d0],0,0,0);
    o[d0]=__builtin_amdgcn_mfma_f32_32x32x16_bf16(pa3,PK(3),o[d0],0,0,0);
    #undef PK
  }
}

#ifndef ATTN_STORE16
#define ATTN_STORE16(p,v) (*(u32x4*)(p)=(v))
#endif
template<int THRL> __device__ __forceinline__ void attn_unit(int qb,const bf16*Qh,const bf16*__restrict__ Kh,const bf16*__restrict__ Vh,bf16*Oh,char*shm,const int tid){
  const int lane=tid&63,r32=lane&31,hi=lane>>5; const int wid=__builtin_amdgcn_readfirstlane(tid>>6);
  const int q0=qb*QB;
  const bf16*Qw=Qh+(long)(q0+wid*QBLK)*DM;
  const unsigned lds0=(unsigned)(uintptr_t)shm;
  float*wsf=(float*)(shm+LDS_WS)+wid*64;
  const bf16*ksrc=Kh+(long)lane*DM+wid*8;
  const bf16*vsrc=Vh+(long)(16*(wid&3)+(lane>>2))*DM+(wid>>2)*32+(lane&3)*8;
  const unsigned kdst=lds0+LDS_K+wid*1024, vdst=lds0+LDS_V+wid*1024;
  #define DMA_K(t,slot) glds16(ksrc+(long)(t)*KVBLK*DM,(unsigned)__builtin_amdgcn_readfirstlane(kdst+(slot)))
  #define DMA_V(t,slot) glds16(vsrc+(long)(t)*KVBLK*DM,(unsigned)__builtin_amdgcn_readfirstlane(vdst+(slot)))
  const bf16*vsrc1=vsrc+64; const unsigned vdst1=lds0+LDS_V1+wid*1024;
  #define DMA_V1(t,slot) glds16(vsrc1+(long)(t)*KVBLK*DM,(unsigned)__builtin_amdgcn_readfirstlane(vdst1+(slot)))
  const int vb0=(int)(lds0+LDS_V)+((lane>>4)&1)*32+(lane&3)*8+(4*hi+((lane&15)>>2))*64;
  const int vb1=vb0+(LDS_V1-LDS_V);
  typedef __attribute__((address_space(3))) f32x4_t* o1ptr_t;
  const char*Kbase=shm+LDS_K; bf16x8 kf[8];
  const lds_cptr shm3=(lds_cptr)shm; const lds_cptr kp0=shm3+LDS_K+hi*1024+r32*16; const lds_cptr vp0=shm3+LDS_V+((lane>>4)&1)*32+(lane&3)*8+(4*hi+((lane&15)>>2))*64;
  const int NT=(q0+QB)/KVBLK;
  DMA_K(0,0);DMA_V(0,0);DMA_V1(0,0);DMA_K(1,SLOTB);
  bf16x8 qr[4];
  #pragma unroll
  for(int d0=0;d0<4;++d0)qr[d0]=*reinterpret_cast<const bf16x8*>(&Qw[(long)r32*DM+d0*16+hi*8]);
  typedef __attribute__((address_space(3))) bf16x8* qptr_t; const qptr_t qlds=(qptr_t)(shm3+LDS_QS+wid*4096)+lane;
  _Pragma("unroll") for(int d0=0;d0<4;++d0)qlds[d0*64]=qr[d0];
  #define QF(d) (qlds[(d)*64])
  float mhat=0.f,l_reg=0.f;f32x16 o[2];o[0]=f32x16{};o[1]=f32x16{};f32x16 o1_[2];o1_[0]=f32x16{};o1_[1]=f32x16{};
 float zf_=0.f;asm volatile("":"+v"(zf_));float nmv=zf_;
  #define NEGM(X) f32x16 X; _Pragma("unroll") for(int r_=0;r_<16;++r_)X[r_]=nmv; asm volatile("":"+v"(X))
  const int qrel=wid*QBLK+r32;
  #define CMASK(P0,P1,t) do{int jb_=(t)-(NT-4); if(jb_>=0)cmask(P0,P1,jb_,qrel,hi);}while(0)
  bool resc=false;
  #define START(P0,P1) do{ const float rm=rowmax(P0,P1); resc=false; \
    { const float dl=rm; mhat=fadd_s(mhat,dl); \
      _Pragma("unroll") for(int r=0;r<16;++r){P0[r]=fsub_s(P0[r],dl);P1[r]=fsub_s(P1[r],dl);} \
      nmv=-mhat; } \
    _Pragma("unroll") for(int r=0;r<16;++r)P0[r]=__builtin_amdgcn_exp2f(P0[r]); }while(0)
  #define RESC() do{ if(resc){ asm volatile("s_waitcnt lgkmcnt(0)":::"memory"); \
      _Pragma("unroll") for(int d_=0;d_<2;++d_) _Pragma("unroll") for(int r=0;r<16;++r){ const float f_=wsf[crow(r,hi)]; o[d_][r]*=f_; o1_[d_][r]*=f_; } } }while(0)
  f32x16 pA0,pA1,pB0,pB1;
  int sl_prev=0,sl_cur=0,sl_next=SLOTB;
  #define ROT() do{sl_prev=sl_cur;sl_cur=sl_next;sl_next=(sl_next==(NSLOT-1)*SLOTB)?0:sl_next+SLOTB;}while(0)
  DMA_K(2,2*SLOTB);
  WAIT_BAR(4);
  { NEGM(ng0_); qkt(pA0,pA1,Kbase,qr,ng0_,r32,hi); }asm volatile("s_nop 15\n\ts_nop 7":"+v"(pA0),"+v"(pA1));CMASK(pA0,pA1,0);
  START(pA0,pA1);
  _Pragma("unroll") for(int r=0;r<16;++r)pA1[r]=__builtin_amdgcn_exp2f(pA1[r]);
  WAIT_BAR(0);
  DMA_K(3,0);DMA_V(1,SLOTB);DMA_V1(1,SLOTB);
  ROT();
  kload8(kf,kp0+sl_cur);
  WAIT_BAR(3);
  s16x4 vlo[8],vhi[8]; u32x4 pw0,pw1,pw2,pw3;
  #define PKW(P,B) cvtpk_s(P[B],P[B+1])
  #define PAF(k) __builtin_bit_cast(bf16x8,pw##k)
  #define VFR(i) (bf16x8){vlo[i][0],vlo[i][1],vlo[i][2],vlo[i][3],vhi[i][0],vhi[i][1],vhi[i][2],vhi[i][3]}
  #define PIN(x) asm volatile("":"+v"(x))
  #define MX3(a,b,c) __builtin_fmaxf(__builtin_fmaxf((a),(b)),(c))
  #define GAPA(MF,A0,A1,A2,A3,W0,W1,PW) do{ MF; sacc+=A0; sacc+=A1; sacc+=A2; sacc+=A3; PIN(sacc); W0; W1; PIN(PW); SBAR(); }while(0)
  #define EX(v) __builtin_amdgcn_exp2f(v)
  #define GAPB(MF,X,B) do{ MF; X[B]=EX(X[B]); X[B+1]=EX(X[B+1]); X[B+2]=EX(X[B+2]); X[B+3]=EX(X[B+3]); PIN(X); SBAR(); }while(0)
  #define GAPB2(MF,X,B) do{ MF; X[B]=EX(X[B]); X[B+1]=EX(X[B+1]); PIN(X); SBAR(); }while(0)
  #define VRD(i) do{ vlo[i]=vtr(vp_+(((i)>>2)*4096+((i)&3)*1024)); vhi[i]=vtr(vp_+(((i)>>2)*4096+((i)&3)*1024+512)); }while(0)
  #define KRD(G,j) do{ if(G){ kload2(kf,kp0+sl_next,j); SBAR(); } }while(0)
  #define VRD1(i) do{ vlo[i]=vtr(vq_+(((i)>>2)*4096+((i)&3)*1024)); vhi[i]=vtr(vq_+(((i)>>2)*4096+((i)&3)*1024+512)); }while(0)
  #define STEP(C0,C1,P0,P1,t,GK,GV,GL) do{ SBAR(); \
    const lds_cptr vp_=vp0+sl_prev; \
    const bf16x8 qa_=QF(0), qb_=QF(1); NEGM(ng_); \
    VRD(0); SBAR(); float sacc=(P0[0]+P0[1]); \
    GAPA(C0=__builtin_amdgcn_mfma_f32_32x32x16_bf16(kf[0],qa_,ng_,0,0,0), P0[2],P0[3],P0[4],P0[5],     pw0[0]=PKW(P0,0), pw0[1]=PKW(P0,2), pw0); \
    VRD(4); SBAR(); GAPA(C1=__builtin_amdgcn_mfma_f32_32x32x16_bf16(kf[1],qa_,ng_,0,0,0), P0[6],P0[7],P0[8],P0[9],     pw0[2]=PKW(P0,4), pw0[3]=PKW(P0,6), pw0); \
    const bf16x8 qc_=QF(2); VRD(1); SBAR(); GAPA(C0=__builtin_amdgcn_mfma_f32_32x32x16_bf16(kf[2],qb_,C0,0,0,0),   P0[10],P0[11],P0[12],P0[13], pw1[0]=PKW(P0,8), pw1[1]=PKW(P0,10), pw1); \
    VRD(5); SBAR(); GAPA(C1=__builtin_amdgcn_mfma_f32_32x32x16_bf16(kf[3],qb_,C1,0,0,0),   P0[14],P0[15],P1[0],P1[1],   pw1[2]=PKW(P0,12),pw1[3]=PKW(P0,14), pw1); \
    const bf16x8 qd_=QF(3); VRD(2); SBAR(); GAPA(C0=__builtin_amdgcn_mfma_f32_32x32x16_bf16(kf[4],qc_,C0,0,0,0),   P1[2],P1[3],P1[4],P1[5],     pw2[0]=PKW(P1,0), pw2[1]=PKW(P1,2), pw2); \
    VRD(6); SBAR(); GAPA(C1=__builtin_amdgcn_mfma_f32_32x32x16_bf16(kf[5],qc_,C1,0,0,0),   P1[6],P1[7],P1[8],P1[9],     pw2[2]=PKW(P1,4), pw2[3]=PKW(P1,6), pw2); \
    VRD(3); SBAR(); GAPA(C0=__builtin_amdgcn_mfma_f32_32x32x16_bf16(kf[6],qd_,C0,0,0,0),   P1[10],P1[11],P1[12],P1[13], pw3[0]=PKW(P1,8), pw3[1]=PKW(P1,10), pw3); \
    VRD(7); SBAR(); GAPA(C1=__builtin_amdgcn_mfma_f32_32x32x16_bf16(kf[7],qd_,C1,0,0,0),   P1[14],P1[15],0.f,0.f,       pw3[2]=PKW(P1,12),pw3[3]=PKW(P1,14), pw3); \
    l_reg+=sacc; \
    if(GK){DMA_K((t)+3,sl_cur);} if(GV){DMA_V((t)+1,sl_next);DMA_V1((t)+1,sl_next);} \
    CMASK(C0,C1,t); \
    { float a=MX3(C0[0],C0[1],C1[0]),b=MX3(C0[2],C0[3],C1[1]); a=MX3(a,C1[2],C1[3]); \
      _Pragma("unroll") for(int r=4;r<16;r+=4){a=MX3(a,C0[r],C0[r+1]);b=MX3(b,C0[r+2],C0[r+3]);a=MX3(a,C1[r],C1[r+1]);b=MX3(b,C1[r+2],C1[r+3]);} \
      float rm=__builtin_fmaxf(a,b); { auto rr=__builtin_amdgcn_permlane32_swap(__float_as_uint(rm),__float_as_uint(rm),false,false); rm=__builtin_fmaxf(__uint_as_float(rr[0]),__uint_as_float(rr[1])); } \
      resc=false; \
      if(__builtin_expect(__any(rm>(float)THRL),0)){ const float dl=__builtin_fmaxf(rm,0.f); mhat+=dl; \
        _Pragma("unroll") for(int r=0;r<16;++r){C0[r]-=dl;C1[r]-=dl;} \
        nmv=-mhat; \
        const float f=__builtin_amdgcn_exp2f(-dl); l_reg*=f; if(hi==0)wsf[r32]=f; resc=true; } } \
    SBAR(); const lds_cptr vq_=vp0+(LDS_V1-LDS_V)+sl_prev; \
    GAPB2(o[0]=__builtin_amdgcn_mfma_f32_32x32x16_bf16(PAF(0),VFR(0),o[0],0,0,0), C0,0); VRD1(0); SBAR(); \
    GAPB2(o[1]=__builtin_amdgcn_mfma_f32_32x32x16_bf16(PAF(0),VFR(4),o[1],0,0,0), C0,2); VRD1(4); SBAR(); \
    KRD(GL,0); GAPB2(o[0]=__builtin_amdgcn_mfma_f32_32x32x16_bf16(PAF(1),VFR(1),o[0],0,0,0), C0,4); VRD1(1); SBAR(); \
    KRD(GL,1); GAPB2(o[1]=__builtin_amdgcn_mfma_f32_32x32x16_bf16(PAF(1),VFR(5),o[1],0,0,0), C0,6); VRD1(5); SBAR(); \
    KRD(GL,2); GAPB2(o[0]=__builtin_amdgcn_mfma_f32_32x32x16_bf16(PAF(2),VFR(2),o[0],0,0,0), C0,8); VRD1(2); SBAR(); \
    KRD(GL,3); GAPB2(o[1]=__builtin_amdgcn_mfma_f32_32x32x16_bf16(PAF(2),VFR(6),o[1],0,0,0), C0,10); VRD1(6); SBAR(); \
    GAPB2(o[0]=__builtin_amdgcn_mfma_f32_32x32x16_bf16(PAF(3),VFR(3),o[0],0,0,0), C0,12); VRD1(3); SBAR(); \
    GAPB2(o[1]=__builtin_amdgcn_mfma_f32_32x32x16_bf16(PAF(3),VFR(7),o[1],0,0,0), C0,14); VRD1(7); SBAR(); \
    GAPB2(o1_[0]=__builtin_amdgcn_mfma_f32_32x32x16_bf16(PAF(0),VFR(0),o1_[0],0,0,0), C1,0); \
    GAPB2(o1_[1]=__builtin_amdgcn_mfma_f32_32x32x16_bf16(PAF(0),VFR(4),o1_[1],0,0,0), C1,2); \
    GAPB2(o1_[0]=__builtin_amdgcn_mfma_f32_32x32x16_bf16(PAF(1),VFR(1),o1_[0],0,0,0), C1,4); \
    GAPB2(o1_[1]=__builtin_amdgcn_mfma_f32_32x32x16_bf16(PAF(1),VFR(5),o1_[1],0,0,0), C1,6); \
    GAPB2(o1_[0]=__builtin_amdgcn_mfma_f32_32x32x16_bf16(PAF(2),VFR(2),o1_[0],0,0,0), C1,8); \
    GAPB2(o1_[1]=__builtin_amdgcn_mfma_f32_32x32x16_bf16(PAF(2),VFR(6),o1_[1],0,0,0), C1,10); \
    GAPB2(o1_[0]=__builtin_amdgcn_mfma_f32_32x32x16_bf16(PAF(3),VFR(3),o1_[0],0,0,0), C1,12); \
    GAPB2(o1_[1]=__builtin_amdgcn_mfma_f32_32x32x16_bf16(PAF(3),VFR(7),o1_[1],0,0,0), C1,14); \
    }while(0)
  int t=1;
  #undef CMASK
  #define CMASK(P0,P1,t) do{}while(0)
  for(;t+5<NT;t+=2){
    STEP(pB0,pB1,pA0,pA1,t,true,true,true);     WAIT_BAR(3); RESC(); ROT();
    STEP(pA0,pA1,pB0,pB1,t+1,true,true,true);   WAIT_BAR(3); RESC(); ROT();
  }
  #undef CMASK
  #define CMASK(P0,P1,t) do{int jb_=(t)-(NT-4); if(jb_>=0)cmask(P0,P1,jb_,qrel,hi);}while(0)
  #define ENDW(tt) do{ if((tt)+3<NT){WAIT_BAR(3);} else if((tt)+2<NT){WAIT_BAR(2);} else {WAIT_BAR(0);} }while(0)
  for(;t+1<NT;t+=2){
    STEP(pB0,pB1,pA0,pA1,t,(t+3<NT),(t+1<NT),(t+1<NT));       ENDW(t);   RESC(); ROT();
    STEP(pA0,pA1,pB0,pB1,t+1,(t+4<NT),(t+2<NT),(t+2<NT));     ENDW(t+1); RESC(); ROT();
  }
  STEP(pB0,pB1,pA0,pA1,NT-1,false,false,false); RESC();
  { float sacc=pB0[0]+pB0[1]; _Pragma("unroll") for(int r=2;r<16;++r)sacc+=pB0[r]; _Pragma("unroll") for(int r=0;r<16;++r)sacc+=pB1[r]; l_reg+=sacc;
    pw0=(u32x4){PKW(pB0,0),PKW(pB0,2),PKW(pB0,4),PKW(pB0,6)};pw1=(u32x4){PKW(pB0,8),PKW(pB0,10),PKW(pB0,12),PKW(pB0,14)};pw2=(u32x4){PKW(pB1,0),PKW(pB1,2),PKW(pB1,4),PKW(pB1,6)};pw3=(u32x4){PKW(pB1,8),PKW(pB1,10),PKW(pB1,12),PKW(pB1,14)};
    SBAR(); pv(o,vb0+sl_cur,PAF(0),PAF(1),PAF(2),PAF(3)); }
  { SBAR(); pv(o1_,vb1+sl_cur,PAF(0),PAF(1),PAF(2),PAF(3)); }
  #undef PKW
  #undef PAF
  #undef VFR
  #undef PIN
  #undef MX3
  #undef GAPA
  #undef GAPB
  #undef EX
  #undef VRD
  #undef KRD
  #undef STEP
  #undef ENDW
  {auto rr=__builtin_amdgcn_permlane32_swap(__float_as_uint(l_reg),__float_as_uint(l_reg),false,false);l_reg=__uint_as_float(rr[0])+__uint_as_float(rr[1]);}
  if(hi==0)wsf[32+r32]=l_reg;asm volatile("s_waitcnt lgkmcnt(0)":::"memory");
  float rli[16];
  #pragma unroll
  for(int r=0;r<16;++r)rli[r]=__builtin_amdgcn_rcpf(wsf[32+crow(r,hi)]);
  bf16*Ow=Oh+(long)(q0+wid*QBLK)*DM;
  asm volatile("s_waitcnt lgkmcnt(0)\n\ts_barrier":::"memory");
  _Pragma("unroll") for(int hf=0;hf<2;++hf)
  { bf16*stg=(bf16*)(shm+LDS_OST)+wid*2048;
    #pragma unroll
    for(int r=0;r<16;++r){const int orow=crow(r,hi);
      #pragma unroll
      for(int d0=0;d0<2;++d0)stg[orow*64+d0*32+r32]=__float2bfloat16((hf?o1_[d0][r]:o[d0][r])*rli[r]);}
    asm volatile("s_waitcnt lgkmcnt(0)":::"memory");
    #pragma unroll
    for(int i=0;i<4;++i){const int row=i*8+(lane>>3),ch=lane&7; const u32x4 v=*(const u32x4*)(stg+row*64+ch*8); ATTN_STORE16(Ow+(long)row*DM+hf*64+ch*8,v);}
    asm volatile("s_waitcnt lgkmcnt(0)":::"memory"); }
  asm volatile("s_waitcnt lgkmcnt(0)\n\ts_barrier":::"memory");
  #undef DMA_K
  #undef DMA_V
  #undef DMA_V1
  #undef QF
  #undef NEGM
  #undef GAPB2
  #undef VRD1
  #undef CMASK
  #undef START
  #undef RESC
  #undef ROT
}
constexpr int ATTN_LDS_BYTES=LDS_BYTES;
#undef SBAR
#undef WAIT_BAR
}
#define LAS __attribute__((address_space(3)))
#define GAS __attribute__((address_space(1)))
typedef unsigned short bf16;
typedef unsigned v4u __attribute__((ext_vector_type(4)));
typedef unsigned v2u __attribute__((ext_vector_type(2)));
typedef float f32x4 __attribute__((ext_vector_type(4)));
#ifndef MK_SINGLE
#define MK_SINGLE 1
#endif
constexpr int NWAVES = 8;
constexpr int L = 16400, LP = 16640, TP = 16512, NCH = 129, CHT = 128, NMETA = 16, NPH = 45;
constexpr size_t MiB = 1u << 20, HMiB = 1u << 19;
constexpr size_t WS_HM = HMiB, WS_WIN = 1 * MiB, WS_WOUT = 7 * MiB, WS_W1 = 9 * MiB, WS_W2 = 17 * MiB, WS_WLR = 25 * MiB, WS_WPOOL = 26 * MiB;
constexpr size_t WS_XN = 27 * MiB, WS_PRQ = 27 * MiB, WS_DP = 27 * MiB, WS_Z = 43 * MiB + HMiB;
constexpr size_t WS_Y = 59 * MiB + HMiB, WS_LR = WS_Y, WS_PP = WS_Y, WS_M1E = WS_Y, WS_F = WS_Y, WS_OZO = WS_Y;
constexpr size_t WS_OZE = 108 * MiB + HMiB, WS_BON = 141 * MiB, WS_REC = 143 * MiB;
constexpr size_t WS_GPP = 92 * MiB;
constexpr size_t WS_Q = 92 * MiB, WS_K = 124 * MiB + HMiB, WS_V = 157 * MiB, WS_O0 = 189 * MiB + HMiB, WS_O1 = 222 * MiB, WS_M1O = 92 * MiB, WS_HID = 92 * MiB;
constexpr size_t WS_END = 256 * MiB;
constexpr size_t ACT_BYTES = (size_t)LP * 1024 * 2;
static_assert(WS_PRQ + (size_t)TP * 8 * 128 * 2 <= WS_Y && WS_REC + (size_t)TP * 8 * 448 * 2 <= WS_END && WS_O1 + ACT_BYTES <= WS_END && WS_HID + 4 * ACT_BYTES <= WS_END, "ws map");
static_assert(WS_Y + (size_t)LP * 2304 * 2 <= WS_REC && WS_LR + (size_t)LP * 1536 * 2 <= WS_OZE && WS_OZE + ACT_BYTES <= WS_BON && WS_K - WS_Q == ACT_BYTES && WS_V - WS_K == ACT_BYTES, "ws map 2");
constexpr int LDS_BYTES = 147456;
constexpr float C2Q = 0.125f * 1.4426950408889634f;

__device__ __forceinline__ unsigned f2bf(float f) { unsigned u = __builtin_bit_cast(unsigned, f); return (u + 0x7fffu + ((u >> 16) & 1u)) >> 16; }
__device__ __forceinline__ unsigned pk2(float lo, float hi) { return f2bf(lo) | (f2bf(hi) << 16); }
__device__ __forceinline__ float bf2f(bf16 b) { return __builtin_bit_cast(float, (unsigned)b << 16); }
__device__ __forceinline__ float bflo(unsigned w) { return __builtin_bit_cast(float, w << 16); }
__device__ __forceinline__ float bfhi(unsigned w) { return __builtin_bit_cast(float, w & 0xffff0000u); }
__device__ __forceinline__ float wave_sum(float v) {
#pragma unroll
    for (int o = 1; o < 64; o <<= 1) v += __shfl_xor(v, o);
    return v;
}
__device__ __forceinline__ void st16_wt(void* p, v4u v) { asm volatile("global_store_dwordx4 %0, %1, off sc1\n\ts_nop 1" :: "v"(p), "v"(v) : "memory"); }
__device__ __forceinline__ void st16_wt(void* p, f32x4 v) { st16_wt(p, __builtin_bit_cast(v4u, v)); }
__device__ __forceinline__ void st8_wt(void* p, v2u v) { asm volatile("global_store_dwordx2 %0, %1, off sc1\n\ts_nop 1" :: "v"(p), "v"(v) : "memory"); }
struct Args { const float* in[24]; float* out; unsigned char* ws; int ph_lo, ph_hi; };
__device__ __forceinline__ const float* inp_ptr(const Args& a, int i) { asm volatile("" : "+s"(i)); return a.in[i]; }

__device__ __forceinline__ void transpose_item(const float* W, int K, int N, bf16* WT, LAS float* scr, int item, int lane, int perm_rows = 0) {
    const int nblk = N / 32, kb = item / nblk, nb = item % nblk, k0 = 64 * kb, n0 = 32 * nb;
#pragma unroll 8
    for (int i = 0; i < 32; ++i) { const int kk = 2 * i + (lane >> 5); scr[kk * 33 + (lane & 31)] = W[(size_t)(k0 + kk) * N + n0 + (lane & 31)]; }
    asm volatile("s_waitcnt lgkmcnt(0)" ::: "memory");
    const int c = lane & 7;
#pragma unroll
    for (int j = 0; j < 4; ++j) { const int n = (lane >> 3) + 8 * j; const LAS float* s = scr + (8 * c) * 33 + n;
        v4u o; o.x = pk2(s[0 * 33], s[1 * 33]); o.y = pk2(s[2 * 33], s[3 * 33]); o.z = pk2(s[4 * 33], s[5 * 33]); o.w = pk2(s[6 * 33], s[7 * 33]);
        int nr = n0 + n; if (nr < perm_rows) { const int d = nr & 63; nr = (nr & ~63) + ((d < 32) ? 2 * d : 2 * (d - 32) + 1); }
        *(v4u*)(WT + (size_t)nr * K + k0 + 8 * c) = o; }
    asm volatile("s_waitcnt lgkmcnt(0)" ::: "memory");
}
__device__ __forceinline__ void wconv(const Args& a, int layer, LAS float* scr, int gw, int NGW, int lane, int gtid, int NTHR) {
    const int j = layer >> 1; const bool odd = layer & 1; unsigned char* ws = a.ws;
    const float* Win = odd ? inp_ptr(a, 20) + (size_t)j * 1024 * 3072 : inp_ptr(a, 5) + (size_t)j * 1024 * 2304; const int Nin = odd ? 3072 : 2304;
    const float* Wout = (odd ? inp_ptr(a, 23) : inp_ptr(a, 19)) + (size_t)j * 1024 * 1024;
    const float* W1 = inp_ptr(a, 3) + (size_t)layer * 1024 * 4096; const float* W2 = inp_ptr(a, 4) + (size_t)layer * 4096 * 1024;
    const int I_in = 16 * (Nin / 32), I_out = 16 * 32, I_1 = 16 * 128, I_2 = 64 * 32;
    const int it_hi = odd ? I_in + I_out + I_1 + I_2 : I_in + I_out;
    const int it_lo = (odd && (NGW >> 3) == 256) ? I_in : 0;
    for (int it = it_lo + gw; it < it_hi; it += NGW) {
        int r = it;
        if (r < I_in) { transpose_item(Win, 1024, Nin, (bf16*)(ws + WS_WIN), scr, r, lane, odd ? 2048 : 0); continue; } r -= I_in;
        if (r < I_out) { transpose_item(Wout, 1024, 1024, (bf16*)(ws + WS_WOUT), scr, r, lane); continue; } r -= I_out;
        if (r < I_1) { transpose_item(W1, 1024, 4096, (bf16*)(ws + WS_W1), scr, r, lane); continue; } r -= I_1;
        transpose_item(W2, 4096, 1024, (bf16*)(ws + WS_W2), scr, r, lane);
    }
    if (!odd) {
        const float* w_up = inp_ptr(a, 8) + (size_t)j * 64 * 512; const float* a_up = inp_ptr(a, 10) + (size_t)j * 64 * 512; const float* g_up = inp_ptr(a, 11) + (size_t)j * 128 * 512;
        const float* pw = inp_ptr(a, 17) + (size_t)j * 4 * 128 * 128;
        bf16* WLR = (bf16*)(ws + WS_WLR); bf16* WPL = (bf16*)(ws + WS_WPOOL);
        for (int idx = gtid; idx < 1536 * 256; idx += NTHR) { const int n = idx >> 8, k = idx & 255; float v = 0.f;
            if (n < 512) { if (k < 64) v = w_up[k * 512 + n]; }
            else if (n < 1024) { if (k >= 64 && k < 128) v = a_up[(k - 64) * 512 + (n - 512)]; }
            else { if (k >= 128) v = g_up[(k - 128) * 512 + (n - 1024)]; }
            WLR[idx] = (bf16)f2bf(v); }
        for (int idx = gtid; idx < 512 * 512; idx += NTHR) { const int n = idx >> 9, k = idx & 511; const int g = n >> 7; float v = 0.f;
            if ((k >> 7) == g) v = pw[((size_t)g * 128 + (k & 127)) * 128 + (n & 127)];
            WPL[idx] = (bf16)f2bf(v); }
    }
}
__device__ __forceinline__ void wconv_mlp(const Args& a, int layer, int part, LAS float* scr, int widx, int nwork, int lane) {
    unsigned char* ws = a.ws;
    if (part == 0) { const float* W1 = inp_ptr(a, 3) + (size_t)layer * 1024 * 4096;
        for (int it = widx; it < 16 * 128; it += nwork) transpose_item(W1, 1024, 4096, (bf16*)(ws + WS_W1), scr, it, lane); }
    else { const float* W2 = inp_ptr(a, 4) + (size_t)layer * 4096 * 1024;
        for (int it = (part - 1) * 1024 + widx; it < part * 1024; it += nwork) transpose_item(W2, 4096, 1024, (bf16*)(ws + WS_W2), scr, it, lane); }
}
__device__ __forceinline__ void wconv_win(const Args& a, int odd_layer, LAS float* scr, int widx, int nwork, int lane) {
    const float* Win = inp_ptr(a, 20) + (size_t)(odd_layer >> 1) * 1024 * 3072;
    for (int it = widx; it < 16 * 96; it += nwork) transpose_item(Win, 1024, 3072, (bf16*)(a.ws + WS_WIN), scr, it, lane, 2048);
}
typedef short bf16x8_t __attribute__((ext_vector_type(8)));
__device__ __forceinline__ void thin_gemm(const bf16* A, const bf16* Bt, int N, int K, bf16* O, int ldc, const float* cscale, int split_cols, size_t split_stride, int act, int rope, LAS float* red, int vcu, int G, int tid, int wave, int lane) {
    const int ntile = N >> 4, ks = K >> 3, lr = lane & 15, lq = lane >> 4;
    for (int tile = vcu; tile < ntile; tile += G) {
        const bf16* ap = A + (size_t)lr * K + wave * ks + 8 * lq; const bf16* bp = Bt + (size_t)(tile * 16 + lr) * K + wave * ks + 8 * lq;
        f32x4 acc = {0.f, 0.f, 0.f, 0.f};
        for (int k = 0; k < ks; k += 32) { const bf16x8_t av = *(const bf16x8_t*)(ap + k), bv = *(const bf16x8_t*)(bp + k); acc = __builtin_amdgcn_mfma_f32_16x16x32_bf16(av, bv, acc, 0, 0, 0); }
#pragma unroll
        for (int r = 0; r < 4; ++r) red[wave * 256 + (4 * lq + r) * 16 + lr] = acc[r];
        __syncthreads();
        if (tid < 256) { float s = 0.f;
#pragma unroll
            for (int w = 0; w < 8; ++w) s += red[w * 256 + tid];
            const int m = tid >> 4; int col = tile * 16 + (tid & 15);
            if (act == 1) { s = fmaxf(s, 0.f); s = s * s; }
            if (cscale) s *= cscale[col];
            bf16* base = O; int tsel = 0; if (split_cols) { const int tt = col / split_cols; base += (size_t)tt * split_stride; col -= tt * split_cols; tsel = tt; }
            { const float other = __shfl_xor(s, 1);
              if (rope && tsel < 2) { const int jj = (col & 63) >> 1; const float inv = expf(-(float)jj * (9.210340371976184f / 32.f)); const float ang = (float)m * inv; const double rev = (double)ang * 0.15915494309189535; const float fr_ = (float)(rev - __builtin_rint(rev));
                  const float qs = tsel == 0 ? 0.18033688011112042f : 1.f; const float cs = __builtin_amdgcn_cosf(fr_) * qs, sn = __builtin_amdgcn_sinf(fr_) * qs;
                  s = (col & 1) ? (s * cs + other * sn) : (s * cs - other * sn); } }
            base[(size_t)m * ldc + col] = (bf16)f2bf(s); }
        __syncthreads();
    }
}
__device__ __forceinline__ void norm_rows(int mode, const float* xin, const float* meta, float* out, float* hm, const bf16* Msrc, const float* ga, const float* gb, bf16* XN, int gw, int NGW, int lane) {
    for (int t = gw; t < L; t += NGW) {
        v2u* xo = (v2u*)(XN + (size_t)t * 1024) + lane;
        if (mode == 2 && t < NMETA) continue;
        float* hrow = t < NMETA ? hm + (size_t)t * 1024 : out + (size_t)(t - NMETA) * 1024;
        f32x4 v[4];
        const float* hsrc = (mode == 0 || mode == 3) ? (t < NMETA ? meta + (size_t)t * 1024 : xin + (size_t)(t - NMETA) * 1024) : hrow;
        if (mode == 0) {
#pragma unroll
            for (int j = 0; j < 4; ++j) v[j] = ((const f32x4*)hsrc)[lane + 64 * j]; }
        else { const v2u* mp = (const v2u*)(Msrc + (size_t)t * 1024) + lane; f32x4 m[4]; float ss = 0.f;
#pragma unroll
            for (int j = 0; j < 4; ++j) { const v2u w = mp[64 * j]; m[j] = (f32x4){bflo(w.x), bfhi(w.x), bflo(w.y), bfhi(w.y)}; ss += (m[j].x * m[j].x + m[j].y * m[j].y) + (m[j].z * m[j].z + m[j].w * m[j].w); }
            const float rs = 1.0f / sqrtf(wave_sum(ss) * (1.f / 1024.f) + 1e-6f);
#pragma unroll
            for (int j = 0; j < 4; ++j) { const f32x4 g = ((const f32x4*)ga)[lane + 64 * j]; const f32x4 hv = ((const f32x4*)hsrc)[lane + 64 * j]; v[j] = hv + m[j] * rs * g; st16_wt((f32x4*)hrow + lane + 64 * j, v[j]); } }
        if (mode != 2) { float s2 = 0.f;
#pragma unroll
            for (int j = 0; j < 4; ++j) s2 += (v[j].x * v[j].x + v[j].y * v[j].y) + (v[j].z * v[j].z + v[j].w * v[j].w);
            const float r2 = 1.0f / sqrtf(wave_sum(s2) * (1.f / 1024.f) + 1e-6f);
#pragma unroll
            for (int j = 0; j < 4; ++j) { const f32x4 g = ((const f32x4*)gb)[lane + 64 * j]; const f32x4 o = v[j] * r2 * g; st8_wt(xo + 64 * j, (v2u){pk2(o.x, o.y), pk2(o.z, o.w)}); } }
    }
}
__device__ __forceinline__ void unpack8(const v4u w, float (&f)[8]) { f[0] = bflo(w.x); f[1] = bfhi(w.x); f[2] = bflo(w.y); f[3] = bfhi(w.y); f[4] = bflo(w.z); f[5] = bfhi(w.z); f[6] = bflo(w.w); f[7] = bfhi(w.w); }
__device__ __forceinline__ v4u pack8(const float (&f)[8]) { v4u o; o.x = pk2(f[0], f[1]); o.y = pk2(f[2], f[3]); o.z = pk2(f[4], f[5]); o.w = pk2(f[6], f[7]); return o; }
__device__ __forceinline__ void shift_rows(const bf16* Y, const float* mu, bf16* REC, bf16* Z, bf16* DP, int gw, int NGW, int lane) {
    for (int t = gw; t < L; t += NGW) {
        const bf16* y = Y + (size_t)t * 2304; const bool hp = t > 0;
        v4u cur[4], prv[4];
#pragma unroll
        for (int q = 0; q < 4; ++q) { const int ci = q * 64 + lane; const bool ok = ci < 224;
            cur[q] = ok ? *(const v4u*)(y + 8 * ci) : (v4u){0u, 0u, 0u, 0u}; prv[q] = (ok && hp) ? *(const v4u*)(y - 2304 + 8 * ci) : (v4u){0u, 0u, 0u, 0u}; }
        float ps[8] = {0.f, 0.f, 0.f, 0.f, 0.f, 0.f, 0.f, 0.f}, pc[8];
        { const int win = 2 << (lane >> 4); const int n = (t + 1) < win ? (t + 1) : win; const bf16* yp = y + 1792 + 8 * lane;
          { float f[8]; unpack8(*(const v4u*)yp, f);
#pragma unroll
            for (int e = 0; e < 8; ++e) { pc[e] = f[e]; ps[e] = f[e]; } }
          for (int s = 1; s < n; ++s) { float f[8]; unpack8(*(const v4u*)(yp - (ptrdiff_t)s * 2304), f);
#pragma unroll
            for (int e = 0; e < 8; ++e) ps[e] += f[e]; }
          const float rn = 1.f / (float)n; float o[8];
#pragma unroll
          for (int e = 0; e < 8; ++e) o[e] = ps[e] * rn - pc[e];
          *(v4u*)(DP + (size_t)t * 512 + 8 * lane) = pack8(o); }
#pragma unroll
        for (int q = 0; q < 4; ++q) { const int ci = q * 64 + lane; if (ci < 224) {
            const int c0 = 8 * ci; float a[8], b[8], o[8]; unpack8(cur[q], a); unpack8(prv[q], b);
            const f32x4 m0 = *(const f32x4*)(mu + c0), m1 = *(const f32x4*)(mu + c0 + 4); const float mm[8] = {m0.x, m0.y, m0.z, m0.w, m1.x, m1.y, m1.z, m1.w};
#pragma unroll
            for (int e = 0; e < 8; ++e) o[e] = a[e] + (b[e] - a[e]) * mm[e];
            if (c0 < 1536) { if (t < TP) { const int vec = c0 >> 9, hh = (c0 & 511) >> 6, i0 = c0 & 63; const int slot = vec == 0 ? 0 : (vec == 1 ? 2 : 3);
                    *(v4u*)(REC + (((size_t)hh * TP + t) * 7 + slot) * 64 + i0) = pack8(o); } }
            else { const int zc = c0 - 1536;
                if (zc < 64) {
#pragma unroll
                    for (int e = 0; e < 8; ++e) o[e] = tanhf(o[e]); }
                else if (zc >= 128) {
#pragma unroll
                    for (int e = 0; e < 8; ++e) o[e] = 1.f / (1.f + __expf(-o[e])); }
                *(v4u*)(Z + (size_t)t * 256 + zc) = pack8(o); } } }
    }
}
__device__ __forceinline__ void prep_rows(const bf16* LR, bf16* REC, float* BON, const float* w0, const float* a0, const float* k_k, const float* k_a, const float* r_k, int gw, int NGW, int lane) {
    const int hh = lane >> 3, i0 = (lane & 7) * 8, c0 = hh * 64 + i0;
    float pw0[8], pa0[8], pkk[8], pka[8], prk[8];
#pragma unroll
    for (int e = 0; e < 8; ++e) { pw0[e] = w0[c0 + e]; pa0[e] = a0[c0 + e]; pkk[e] = k_k[c0 + e]; pka[e] = k_a[c0 + e]; prk[e] = r_k[c0 + e]; }
    for (int t = gw; t < L; t += NGW) {
        bf16* rec = REC + ((size_t)hh * TP + t) * 448 + i0; const bf16* lr = LR + (size_t)t * 1536 + c0;
        float r[8], kr[8], lw[8], la[8], lg[8];
        unpack8(*(const v4u*)rec, r); unpack8(*(const v4u*)(rec + 128), kr); unpack8(*(const v4u*)lr, lw); unpack8(*(const v4u*)(lr + 512), la); unpack8(*(const v4u*)(lr + 1024), lg);
        float ev[8], kv[8], kk[8], bb[8]; float nsq = 0.f, bon = 0.f;
#pragma unroll
        for (int e = 0; e < 8; ++e) {
            const float nx = -(pw0[e] + lw[e]); const float sp = fmaxf(nx, 0.f) + log1pf(__expf(-fabsf(nx)));
            ev[e] = __expf(-sp - 0.5f);
            const float av = 1.f / (1.f + __expf(-(pa0[e] + la[e])));
            kk[e] = kr[e] * pkk[e]; nsq += kk[e] * kk[e];
            kv[e] = kr[e] * (1.f + (av - 1.f) * pka[e]); bon += r[e] * kv[e] * prk[e]; bb[e] = av; }
        nsq += __shfl_xor(nsq, 1); nsq += __shfl_xor(nsq, 2); nsq += __shfl_xor(nsq, 4);
        bon += __shfl_xor(bon, 1); bon += __shfl_xor(bon, 2); bon += __shfl_xor(bon, 4);
        const float rn = 1.f / fmaxf(sqrtf(nsq), 1e-12f);
#pragma unroll
        for (int e = 0; e < 8; ++e) { kk[e] *= rn; bb[e] *= kk[e]; }
        *(v4u*)(rec + 64) = pack8(ev); *(v4u*)(rec + 128) = pack8(kv); *(v4u*)(rec + 256) = pack8(kk); *(v4u*)(rec + 320) = pack8(bb); *(v4u*)(rec + 384) = pack8(lg);
        if ((lane & 7) == 0) BON[hh * TP + t] = bon;
    }
}
__device__ __forceinline__ void scan_stage(const bf16* rec_h, int t0, LAS float* wl, int lane) {
    const v4u* src = (const v4u*)(rec_h + (size_t)t0 * 448);
#pragma unroll
    for (int q = 0; q < 7; ++q) {
        const int ci = q * 64 + lane; const v4u raw = src[ci]; const bool isw = ((ci % 56) >> 3) == 1;
        float f[8] = {bflo(raw.x), bfhi(raw.x), bflo(raw.y), bfhi(raw.y), bflo(raw.z), bfhi(raw.z), bflo(raw.w), bfhi(raw.w)};
        if (isw) {
#pragma unroll
            for (int e = 0; e < 8; ++e) f[e] = __expf(-f[e]); }
        LAS f32x4* dst = (LAS f32x4*)(wl + ci * 8);
        dst[0] = (f32x4){f[0], f[1], f[2], f[3]}; dst[1] = (f32x4){f[4], f[5], f[6], f[7]};
    }
}
__device__ __forceinline__ float half_sum(float x) { return x + __shfl_xor(x, 32); }
__device__ __forceinline__ void scan1(const bf16* REC, float* PP, bf16* PRQ, LAS float* wl, int gw, int NGW, int lane) {
    for (int task = gw; task < NCH * 16; task += NGW) {
        asm volatile("" : "+v"(lane));
        const int c = task >> 4, hh = (task >> 1) & 7, rh = task & 1, kh = lane >> 5, row = 32 * rh + (lane & 31); const bf16* rec_h = REC + (size_t)hh * TP * 448;
        float P[32], Q[32];
#pragma unroll
        for (int k = 0; k < 32; ++k) { P[k] = (32 * kh + k == row) ? 1.f : 0.f; Q[k] = 0.f; }
        const int tend = (c + 1) * CHT < L ? (c + 1) * CHT : L;
        for (int t0 = c * CHT; t0 < tend; t0 += 8) {
            scan_stage(rec_h, t0, wl, lane);
#pragma unroll 1
            for (int s = 0; s < 8; ++s) {
                const LAS float* b = wl + s * 448 + 32 * kh; const float vv = wl[s * 448 + 192 + row];
                f32x4 kk8[8], w8[8], b8[8], k8[8];
#pragma unroll
                for (int q = 0; q < 8; ++q) kk8[q] = *(const LAS f32x4*)(b + 256 + 4 * q);
#pragma unroll
                for (int q = 0; q < 8; ++q) { w8[q] = *(const LAS f32x4*)(b + 64 + 4 * q); b8[q] = *(const LAS f32x4*)(b + 320 + 4 * q); k8[q] = *(const LAS f32x4*)(b + 128 + 4 * q); }
                float sp0 = 0.f, sp1 = 0.f, sq0 = 0.f, sq1 = 0.f;
#pragma unroll
                for (int q = 0; q < 8; ++q) { sp0 += P[4 * q] * kk8[q].x; sp1 += P[4 * q + 1] * kk8[q].y; sp0 += P[4 * q + 2] * kk8[q].z; sp1 += P[4 * q + 3] * kk8[q].w;
                    sq0 += Q[4 * q] * kk8[q].x; sq1 += Q[4 * q + 1] * kk8[q].y; sq0 += Q[4 * q + 2] * kk8[q].z; sq1 += Q[4 * q + 3] * kk8[q].w; }
                const float sap = -half_sum(sp0 + sp1), saq = -half_sum(sq0 + sq1);
                f32x4 r8[8];
#pragma unroll
                for (int q = 0; q < 8; ++q) r8[q] = *(const LAS f32x4*)(b + 4 * q);
#pragma unroll
                for (int q = 0; q < 8; ++q)
#pragma unroll
                    for (int e = 0; e < 4; ++e) { P[4 * q + e] = P[4 * q + e] * w8[q][e] + sap * b8[q][e]; Q[4 * q + e] = Q[4 * q + e] * w8[q][e] + (saq * b8[q][e] + vv * k8[q][e]); }
                float pr0 = 0.f, pr1 = 0.f, qr0 = 0.f, qr1 = 0.f;
#pragma unroll
                for (int q = 0; q < 8; ++q) { pr0 += P[4 * q] * r8[q].x; pr1 += P[4 * q + 1] * r8[q].y; pr0 += P[4 * q + 2] * r8[q].z; pr1 += P[4 * q + 3] * r8[q].w;
                    qr0 += Q[4 * q] * r8[q].x; qr1 += Q[4 * q + 1] * r8[q].y; qr0 += Q[4 * q + 2] * r8[q].z; qr1 += Q[4 * q + 3] * r8[q].w; }
                const float prs = half_sum(pr0 + pr1), qrs = half_sum(qr0 + qr1);
                bf16* pq = PRQ + ((size_t)hh * TP + t0 + s) * 128 + row; pq[kh * 64] = (bf16)f2bf(kh ? qrs : prs);
            }
        }
        f32x4* po = (f32x4*)(PP + ((size_t)(c * 8 + hh) * 2) * 4096 + (size_t)row * 64 + 32 * kh); f32x4* qo = po + 1024;
#pragma unroll
        for (int q = 0; q < 8; ++q) { po[q] = (f32x4){P[4 * q], P[4 * q + 1], P[4 * q + 2], P[4 * q + 3]}; qo[q] = (f32x4){Q[4 * q], Q[4 * q + 1], Q[4 * q + 2], Q[4 * q + 3]}; }
    }
}
template <int NRT> __device__ __forceinline__ void chain(const float* phi, size_t mstride, int nsteps, const float* init_src, float* out_each, size_t out_stride, float* fin, LAS float* sb, int tid, int wave, int lane) {
    constexpr int ROWS = NRT == 4 ? 128 : 64;
    const int lr = lane & 15, lq = lane >> 4, jb = wave >> 1, i0 = (wave & 1) * NRT; const bool qpart = (NRT == 2) || (wave & 1);
    for (int u = tid; u < ROWS * 68; u += 512) { const int r = u / 68, cidx = u - r * 68; float v = 0.f;
        if (NRT == 4) v = (r < 64 && cidx == r) ? 1.f : 0.f; else if (init_src && cidx < 64) v = init_src[r * 64 + cidx];
        sb[u] = v; }
    __syncthreads();
    f32x4 bfr[4], acc[NRT];
    { const f32x4* bp = (const f32x4*)(phi + (16 * jb + lr) * 0 + 0); (void)bp; }
#pragma unroll
    for (int q = 0; q < 4; ++q) { f32x4 t4;
#pragma unroll
        for (int e = 0; e < 4; ++e) t4[e] = phi[(16 * lq + 4 * q + e) * 64 + 16 * jb + lr]; bfr[q] = t4; }
#pragma unroll
    for (int ii = 0; ii < NRT; ++ii)
#pragma unroll
        for (int r = 0; r < 4; ++r) acc[ii][r] = qpart ? phi[4096 + (16 * ((i0 + ii) & 3) + 4 * lq + r) * 64 + 16 * jb + lr] : 0.f;
    int cur = 0;
    for (int s = 0; s < nsteps; ++s) {
        f32x4 nb[4], nacc[NRT]; const bool more = (s + 1) < nsteps; const float* np = phi + (size_t)(more ? s + 1 : s) * mstride;
#pragma unroll
        for (int q = 0; q < 4; ++q) { f32x4 t4;
#pragma unroll
            for (int e = 0; e < 4; ++e) t4[e] = np[(16 * lq + 4 * q + e) * 64 + 16 * jb + lr]; nb[q] = t4; }
#pragma unroll
        for (int ii = 0; ii < NRT; ++ii)
#pragma unroll
            for (int r = 0; r < 4; ++r) nacc[ii][r] = (more && qpart) ? np[4096 + (16 * ((i0 + ii) & 3) + 4 * lq + r) * 64 + 16 * jb + lr] : 0.f;
        const LAS float* S = sb + cur * ROWS * 68;
#pragma unroll
        for (int ii = 0; ii < NRT; ++ii) { const LAS f32x4* ap = (const LAS f32x4*)(S + (16 * (i0 + ii) + lr) * 68 + 16 * lq);
#pragma unroll
            for (int q = 0; q < 4; ++q) { const f32x4 a4 = ap[q];
#pragma unroll
                for (int e = 0; e < 4; ++e) acc[ii] = __builtin_amdgcn_mfma_f32_16x16x4f32(a4[e], bfr[q][e], acc[ii], 0, 0, 0); } }
        LAS float* Sn = sb + (cur ^ 1) * ROWS * 68;
#pragma unroll
        for (int ii = 0; ii < NRT; ++ii)
#pragma unroll
            for (int r = 0; r < 4; ++r) { const int row = 16 * (i0 + ii) + 4 * lq + r, col = 16 * jb + lr; Sn[row * 68 + col] = acc[ii][r];
                if (NRT == 2) out_each[(size_t)s * out_stride + row * 64 + col] = acc[ii][r];
                else if (!more) fin[row * 64 + col] = acc[ii][r]; }
        __syncthreads(); cur ^= 1;
#pragma unroll
        for (int q = 0; q < 4; ++q) bfr[q] = nb[q];
#pragma unroll
        for (int ii = 0; ii < NRT; ++ii) acc[ii] = nacc[ii];
    }
}
__device__ __forceinline__ void scan_out(const bf16* REC, const float* PP, const bf16* PRQ, const float* BON, const float* ln_w, const float* ln_b, bf16* OZ, int vcu, int G, int wave, int lane) {
    const int lr = lane & 15, lq = lane >> 4;
    for (int task = vcu; task < NCH * 8; task += G) {
        const int c = task >> 3, hh = task & 7, t0 = c * CHT + 16 * wave;
        f32x4 acc[4];
#pragma unroll
        for (int nt = 0; nt < 4; ++nt)
#pragma unroll
            for (int r = 0; r < 4; ++r) acc[nt][r] = bf2f(PRQ[((size_t)hh * TP + t0 + 4 * lq + r) * 128 + 64 + 16 * nt + lr]);
        if (c > 0) { const float* S0 = PP + ((size_t)((c - 1) * 8 + hh) * 2 + 1) * 4096; const bf16* pr = PRQ + ((size_t)hh * TP + t0 + lr) * 128 + 16 * lq;
            float av[16]; { float f0[8], f1[8]; unpack8(*(const v4u*)pr, f0); unpack8(*(const v4u*)(pr + 8), f1);
#pragma unroll
                for (int e = 0; e < 8; ++e) { av[e] = f0[e]; av[8 + e] = f1[e]; } }
#pragma unroll
            for (int nt = 0; nt < 4; ++nt) { const f32x4* sp = (const f32x4*)(S0 + (16 * nt + lr) * 64 + 16 * lq); const f32x4 b0 = sp[0], b1 = sp[1], b2 = sp[2], b3 = sp[3];
                const float bv[16] = {b0.x, b0.y, b0.z, b0.w, b1.x, b1.y, b1.z, b1.w, b2.x, b2.y, b2.z, b2.w, b3.x, b3.y, b3.z, b3.w};
#pragma unroll
                for (int kk = 0; kk < 16; ++kk) acc[nt] = __builtin_amdgcn_mfma_f32_16x16x4f32(av[kk], bv[kk], acc[nt], 0, 0, 0); } }
#pragma unroll
        for (int r = 0; r < 4; ++r) { const int t = t0 + 4 * lq + r;
            float s = (acc[0][r] + acc[1][r]) + (acc[2][r] + acc[3][r]); s += __shfl_xor(s, 1); s += __shfl_xor(s, 2); s += __shfl_xor(s, 4); s += __shfl_xor(s, 8);
            const float mean = s * (1.f / 64.f); float d[4], q = 0.f;
#pragma unroll
            for (int nt = 0; nt < 4; ++nt) { d[nt] = acc[nt][r] - mean; q += d[nt] * d[nt]; }
            q += __shfl_xor(q, 1); q += __shfl_xor(q, 2); q += __shfl_xor(q, 4); q += __shfl_xor(q, 8);
            const float rs = 1.0f / sqrtf(q * (1.f / 64.f) + 64e-5f);
            if (t < L) { const float bon = BON[hh * TP + t]; const bf16* rec = REC + ((size_t)hh * TP + t) * 448;
#pragma unroll
                for (int nt = 0; nt < 4; ++nt) { const int v = 16 * nt + lr, cc = hh * 64 + v;
                    const float y = d[nt] * rs * ln_w[cc] + ln_b[cc];
                    OZ[(size_t)t * 1024 + cc] = (bf16)f2bf((y + bon * bf2f(rec[192 + v])) * bf2f(rec[384 + v])); } }
        }
    }
}
__device__ __forceinline__ void zero_pad_rows(bf16* Qb, bf16* Kb, bf16* Vb, int gtid, int NTHR) {
    const v4u z = {0u, 0u, 0u, 0u};
    for (int idx = gtid; idx < (LP - L) * 128; idx += NTHR) { const size_t off = (size_t)L * 1024 + (size_t)idx * 8; *(v4u*)(Qb + off) = z; *(v4u*)(Kb + off) = z; *(v4u*)(Vb + off) = z; }
}
__device__ __forceinline__ void combine_rows(const bf16* O0, const bf16* O1, const float* lamv, const float* subw, float lam_init, bf16* OZ, int gw, int NGW, int lane) {
    const float d01 = wave_sum(lamv[lane] * lamv[64 + lane]), d23 = wave_sum(lamv[128 + lane] * lamv[192 + lane]);
    const float lam = __expf(d01) - __expf(d23) + lam_init; const float post = 1.f - lam_init;
    float sw[16];
#pragma unroll
    for (int k = 0; k < 16; ++k) sw[k] = subw[((lane & 7) * 16) + k] * post;
    for (int t = gw; t < L; t += NGW) {
        const v4u* p0 = (const v4u*)(O0 + (size_t)t * 1024 + lane * 16); const v4u* p1 = (const v4u*)(O1 + (size_t)t * 1024 + lane * 16);
        float o[16]; float ss = 0.f;
#pragma unroll
        for (int h2 = 0; h2 < 2; ++h2) { const v4u a = p0[h2], b = p1[h2];
            const unsigned aw[4] = {a.x, a.y, a.z, a.w}, bw[4] = {b.x, b.y, b.z, b.w};
#pragma unroll
            for (int e = 0; e < 4; ++e) { o[h2 * 8 + 2 * e] = bflo(aw[e]) - lam * bflo(bw[e]); o[h2 * 8 + 2 * e + 1] = bfhi(aw[e]) - lam * bfhi(bw[e]); } }
#pragma unroll
        for (int k = 0; k < 16; ++k) ss += o[k] * o[k];
        ss += __shfl_xor(ss, 1); ss += __shfl_xor(ss, 2); ss += __shfl_xor(ss, 4);
        const float rs = 1.0f / sqrtf(ss * (1.f / 128.f) + 1e-5f);
        v4u w0, w1;
        w0.x = pk2(o[0] * rs * sw[0], o[1] * rs * sw[1]); w0.y = pk2(o[2] * rs * sw[2], o[3] * rs * sw[3]); w0.z = pk2(o[4] * rs * sw[4], o[5] * rs * sw[5]); w0.w = pk2(o[6] * rs * sw[6], o[7] * rs * sw[7]);
        w1.x = pk2(o[8] * rs * sw[8], o[9] * rs * sw[9]); w1.y = pk2(o[10] * rs * sw[10], o[11] * rs * sw[11]); w1.z = pk2(o[12] * rs * sw[12], o[13] * rs * sw[13]); w1.w = pk2(o[14] * rs * sw[14], o[15] * rs * sw[15]);
        v4u* po = (v4u*)(OZ + (size_t)t * 1024 + lane * 16); po[0] = w0; po[1] = w1;
    }
}
#define RLX_AGENT __ATOMIC_RELAXED, __HIP_MEMORY_SCOPE_AGENT
#define LDS_WAIT() asm volatile("s_waitcnt lgkmcnt(0)" ::: "memory")
#define VM_WAIT() asm volatile("s_waitcnt vmcnt(0)" ::: "memory")
__device__ __forceinline__ unsigned long long rt() { return __builtin_amdgcn_s_memrealtime(); }

#define XB_TMO      128
#define XB_XCNT(j)  (256  + 64 * (j))
#define XB_XSUB(j)  (1280 + 64 * (j))
#define XB_XGEN(j)  (2304 + 64 * (j))
#define XB_TOP      3328
#define XB_TOPGEN   3392
#define XCD_BAR_WORDS 3456
#define XB_SPIN_CAP (1u << 18)

__device__ __forceinline__ unsigned xb_ld(unsigned* p)              { return __hip_atomic_load(p, __ATOMIC_RELAXED, __HIP_MEMORY_SCOPE_AGENT); }
__device__ __forceinline__ unsigned xb_add(unsigned* p, unsigned v) { return __hip_atomic_fetch_add(p, v, __ATOMIC_RELAXED, __HIP_MEMORY_SCOPE_AGENT); }
__device__ __forceinline__ unsigned xb_xcc_id() { return (unsigned)__builtin_amdgcn_s_getreg((3 << 11) | 20) & 0xFu; }
#define XB_SPIN(cond, bar) do { unsigned _sp = 0; while (cond) { __builtin_amdgcn_s_sleep(1); \
    if ((++_sp & 255u) == 0u) { if (xb_ld(&(bar)[XB_TMO])) break; if (_sp > XB_SPIN_CAP) { atomicAdd(&(bar)[XB_TMO], 1u); break; } } } } while (0)

struct XcdBarrier {
    unsigned* bar; unsigned x;
    volatile LAS unsigned* st;
};

__device__ __forceinline__ XcdBarrier xcd_barrier_post(unsigned* bar, volatile LAS unsigned* st) {
    XcdBarrier b; b.bar = bar; b.x = xb_xcc_id(); b.st = st;
    if (threadIdx.x == 0) (void)xb_add(&bar[XB_XCNT(b.x)], 1u);
    return b;
}
__device__ __forceinline__ void xcd_barrier_complete(unsigned* bar, unsigned x, unsigned& nloc, unsigned& nx) {
    const unsigned G = gridDim.x * gridDim.y * gridDim.z;
    unsigned sum, cnt, mine, sp = 0u;
    for (;;) {
        sum = 0u; cnt = 0u; mine = 0u;
#pragma unroll
        for (unsigned j = 0; j < 16; ++j) { const unsigned c = xb_ld(&bar[XB_XCNT(j)]); sum += c; cnt += (c > 0u) ? 1u : 0u; mine = (j == x) ? c : mine; }
        if (sum == G) break;
        __builtin_amdgcn_s_sleep(1);
        if ((++sp & 255u) == 0u) { if (xb_ld(&bar[XB_TMO])) break; if (sp > XB_SPIN_CAP) { atomicAdd(&bar[XB_TMO], 1u); break; } }
    }
    nloc = mine > 0u ? mine : 1u; nx = cnt > 0u ? cnt : 1u;
}

__device__ __forceinline__ void xcd_barrier(const XcdBarrier& b) {
    asm volatile("s_waitcnt vmcnt(0)" ::: "memory");
    __syncthreads();
    if (threadIdx.x == 0) {
        unsigned* bar = b.bar;
        __builtin_amdgcn_s_waitcnt(0);
        unsigned nloc = b.st[0], nx = b.st[1];
        if (nloc == 0u) { xcd_barrier_complete(bar, b.x, nloc, nx); b.st[0] = nloc; b.st[1] = nx; }
        const unsigned old = xb_add(&bar[XB_XSUB(b.x)], 1u);
        const unsigned gen = old / nloc;
        if (old + 1u == (gen + 1u) * nloc) {
            __builtin_amdgcn_fence(__ATOMIC_RELEASE, "agent");
            asm volatile("s_waitcnt vmcnt(0)" ::: "memory");
            const unsigned og = xb_add(&bar[XB_TOP], 1u);
            const unsigned tg = og / nx;
            if (og + 1u == (tg + 1u) * nx) xb_add(&bar[XB_TOPGEN], 1u);
            else XB_SPIN(xb_ld(&bar[XB_TOPGEN]) == tg, bar);
            __builtin_amdgcn_fence(__ATOMIC_ACQUIRE, "agent");
            xb_add(&bar[XB_XGEN(b.x)], 1u);
            asm volatile("s_waitcnt vmcnt(0)" ::: "memory");
        } else {
            XB_SPIN(xb_ld(&bar[XB_XGEN(b.x)]) == gen, bar);
            __builtin_amdgcn_fence(__ATOMIC_ACQUIRE, "agent");
            asm volatile("s_waitcnt vmcnt(0)" ::: "memory");
        }
    }
    __syncthreads();
}
#define INP(i) inp_ptr(a, (i))
__global__ void __launch_bounds__(NWAVES * 64, 2) mega_fwd(Args a) {
    extern __shared__ __attribute__((aligned(16))) unsigned char lds[];
    cg::grid_group grid = cg::this_grid();
    LAS unsigned char* ldsl = (LAS unsigned char*)lds;
    const int wave0 = __builtin_amdgcn_readfirstlane(threadIdx.x >> 6);
    volatile LAS unsigned* MISC = (volatile LAS unsigned*)(ldsl + 143360);
    if (threadIdx.x < 16) MISC[threadIdx.x] = 0u;
    __syncthreads();
    XcdBarrier xbar = xcd_barrier_post((unsigned*)a.ws, MISC + 8);
#pragma unroll 1
    for (int pp = a.ph_lo * 2; pp < a.ph_hi * 2; ++pp) {
        const int p = pp >> 1, rep = pp & 1;
        unsigned zs = 0u; asm volatile("" : "+s"(zs));
        const int tid = wave0 * 64 + (int)__builtin_amdgcn_mbcnt_hi(~0u, __builtin_amdgcn_mbcnt_lo(~0u, zs));
        int G = gridDim.x, bx = blockIdx.x; asm volatile("" : "+s"(G), "+s"(bx));
        unsigned char* ws = a.ws; asm volatile("" : "+s"(ws));
        const int wave = wave0;
        const int vcu = (G % 8 == 0) ? (bx % 8) * (G / 8) + bx / 8 : bx;
        const int gw = vcu * NWAVES + wave, NGW = G * NWAVES, NTHR = G * NWAVES * 64;
        LAS float* wl = (LAS float*)(ldsl + wave * 16384);
        bf16* XN = (bf16*)(ws + WS_XN);
        int layer, step;
        if (p < 14) { layer = 0; step = p; } else if (p < 22) { layer = 1; step = p - 14; } else if (p < 36) { layer = 2; step = p - 22; } else if (p < 44) { layer = 3; step = p - 36; } else { layer = 4; step = 0; }
        const bool odd = layer & 1; const int j = layer >> 1;
        const float* ng = INP(2) + (size_t)layer * 4096;
        int kind;
        if (layer == 4) kind = 0;
        else if (!odd) kind = (step == 0 || step == 11) ? 0 : (step == 2) ? 2 : (step == 4) ? 3 : (step == 5) ? 4 : (step == 6) ? 10 : (step == 7) ? 5 : (step == 8) ? 11 : (step == 9) ? 6 : 1;
        else kind = (step == 0 || step == 5) ? 0 : (step == 2) ? 8 : (step == 3) ? 9 : 1;
        if (rep == 1 && !((REP_MASK >> kind) & 1)) continue;
        if (kind == 8) {
            const attn_body::bf16* Qb = (const attn_body::bf16*)(ws + WS_Q); const attn_body::bf16* Kb = (const attn_body::bf16*)(ws + WS_K); const attn_body::bf16* Vb = (const attn_body::bf16*)(ws + WS_V);
            attn_body::bf16* Ob0 = (attn_body::bf16*)(ws + WS_O0); attn_body::bf16* Ob1 = (attn_body::bf16*)(ws + WS_O1);
            const int cpx = G >> 3, xg = vcu / cpx, jx = vcu - xg * cpx;
            for (int r = 0;; ++r) {
                const int ps = r * cpx + ((r & 1) ? (cpx - 1 - jx) : jx); if (ps >= 65 * 2) break;
                const int qb = 64 - (ps >> 1), hh = xg, cc = ps & 1;
                int tid_u = tid; asm volatile("" : "+v"(tid_u));
                attn_body::attn_unit<8>(qb, Qb + hh * 128 + cc * 64, Kb + hh * 128 + cc * 64, Vb + hh * 128, (cc ? Ob1 : Ob0) + hh * 128, (char*)lds, tid_u);
            }
        } else {
        int tid_e = tid; asm volatile("" : "+v"(tid_e));
        const int lane = tid_e & 63, gtid = bx * (NWAVES * 64) + tid_e;
        if (kind == 0) {
            if (layer == 4) norm_rows(2, nullptr, nullptr, a.out, (float*)(ws + WS_HM), (const bf16*)(ws + WS_F), ng - 1024, nullptr, XN, gw, NGW, lane);
            else if (step == 0) {
#pragma unroll 1
                for (int ps_ = 0; ps_ < 2; ++ps_) {
                    if ((ps_ ^ (wave & 1)) == 0) wconv(a, layer, wl, gw, NGW, lane, gtid, NTHR);
                    else norm_rows(layer == 0 ? 0 : 1, INP(0), INP(1), a.out, (float*)(ws + WS_HM), (const bf16*)(ws + WS_F), ng - 1024, ng, XN, gw, NGW, lane);
                }
            } else norm_rows(layer == 0 ? 3 : 1, INP(0), INP(1), a.out, (float*)(ws + WS_HM), (const bf16*)(ws + (odd ? WS_M1O : WS_M1E)), ng + 1024, ng + 2048, XN, gw, NGW, lane);
        } else if (kind == 1) {
            int ng_ = 1;
            const bf16* A0 = XN; const bf16* B0 = (const bf16*)(ws + WS_WIN); int N0 = 2304, K0 = 1024, ldc0 = 2304, act0 = 0, sc0 = 0, rope0 = 0; bf16* O0 = (bf16*)(ws + WS_Y); const float* cs0 = nullptr;
            const bf16* A1 = nullptr; const bf16* B1 = nullptr; int N1 = 0, K1 = 0, ldc1 = 0; bf16* O1 = nullptr; const float* cs1 = nullptr;
            if (!odd) {
                if (step == 3) { ng_ = 2; A0 = (const bf16*)(ws + WS_Z); B0 = (const bf16*)(ws + WS_WLR); N0 = 1536; K0 = 256; ldc0 = 1536; O0 = (bf16*)(ws + WS_LR);
                                 A1 = (const bf16*)(ws + WS_DP); B1 = (const bf16*)(ws + WS_WPOOL); N1 = 512; K1 = 512; ldc1 = 1024; O1 = (bf16*)(ws + WS_OZE) + 512; cs1 = INP(18) + (size_t)j * 512; }
                else if (step == 10) { A0 = (const bf16*)(ws + WS_OZE); B0 = (const bf16*)(ws + WS_WOUT); N0 = 1024; ldc0 = 1024; O0 = (bf16*)(ws + WS_M1E); }
            } else {
                if (step == 1) { N0 = 3072; ldc0 = 1024; sc0 = 1024; O0 = (bf16*)(ws + WS_Q); rope0 = 1; }
                else if (step == 4) { A0 = (const bf16*)(ws + WS_OZO); B0 = (const bf16*)(ws + WS_WOUT); N0 = 1024; ldc0 = 1024; O0 = (bf16*)(ws + WS_M1O); }
            }
            const int mstep = odd ? step - 6 : step - 12;
            if (mstep == 0) { B0 = (const bf16*)(ws + WS_W1); N0 = 4096; ldc0 = 4096; act0 = 1; O0 = (bf16*)(ws + WS_HID); }
            else if (mstep == 1) { A0 = (const bf16*)(ws + WS_HID); B0 = (const bf16*)(ws + WS_W2); N0 = 1024; K0 = 4096; ldc0 = 1024; O0 = (bf16*)(ws + WS_F); }
#pragma unroll 1
            for (int q = 0; q < ng_; ++q) {
                const bf16* Aq = q ? A1 : A0; const bf16* Bq = q ? B1 : B0; bf16* Oq = q ? O1 : O0; const int Nq = q ? N1 : N0, Kq = q ? K1 : K0, ldq = q ? ldc1 : ldc0, scq = q ? 0 : sc0, actq = q ? 0 : act0; const float* csq = q ? cs1 : cs0;
                { int tid_t = tid; asm volatile("" : "+v"(tid_t));
                  thin_gemm(Aq, Bq, Nq, Kq, Oq, ldq, csq, scq, ACT_BYTES / 2, actq, q ? 0 : rope0, (LAS float*)ldsl, vcu, G, tid_t, wave, tid_t & 63); }
                pg8::Gemm g{Aq + (size_t)NMETA * Kq, Bq, 16384, Nq, Kq}; pg8::StaticOrder S; S.init(16384, g.N, G, bx);
                pg8::EpiBf16 E{Oq + (size_t)NMETA * ldq, ldq, csq, scq, ACT_BYTES / 2, actq, q ? 0 : rope0, NMETA};
                { unsigned z3 = 0u; asm volatile("" : "+s"(z3)); const int tid_g = wave0 * 64 + (int)__builtin_amdgcn_mbcnt_hi(~0u, __builtin_amdgcn_mbcnt_lo(~0u, z3));
                  pg8::gemm_phase<pg8::EpiBf16, pg8::StaticOrder, true, true>(ldsl, g, S, E, tid_g); }
            }
            if (!odd && step == 3 && G == 256 && bx >= 128) { unsigned z4 = 0u; asm volatile("" : "+s"(z4)); const int ln_ = (int)__builtin_amdgcn_mbcnt_hi(~0u, __builtin_amdgcn_mbcnt_lo(~0u, z4));
                wconv_win(a, layer + 1, wl, (bx - 128) * NWAVES + wave, (G - 128) * NWAVES, ln_); }
            if (rope0) { unsigned z2 = 0u; asm volatile("" : "+s"(z2)); const int tid_z = wave0 * 64 + (int)__builtin_amdgcn_mbcnt_hi(~0u, __builtin_amdgcn_mbcnt_lo(~0u, z2));
                zero_pad_rows((bf16*)(ws + WS_Q), (bf16*)(ws + WS_K), (bf16*)(ws + WS_V), bx * (NWAVES * 64) + tid_z, NTHR); }
        } else if (kind == 2) {
            shift_rows((const bf16*)(ws + WS_Y), INP(6) + (size_t)j * 1792, (bf16*)(ws + WS_REC), (bf16*)(ws + WS_Z), (bf16*)(ws + WS_DP), gw, NGW, lane);
        } else if (kind == 3) {
            prep_rows((const bf16*)(ws + WS_LR), (bf16*)(ws + WS_REC), (float*)(ws + WS_BON), INP(7) + j * 512, INP(9) + j * 512, INP(12) + j * 512, INP(13) + j * 512, INP(14) + j * 512, gw, NGW, lane);
        } else if (kind == 4) {
            scan1((const bf16*)(ws + WS_REC), (float*)(ws + WS_PP), (bf16*)(ws + WS_PRQ), wl, gw, NGW, lane);
        } else if (kind == 10) {
            if (vcu >= 128) wconv_mlp(a, layer, 1, wl, (vcu - 128) * NWAVES + wave, (G - 128) * NWAVES, lane);
            if (vcu < 128) { const int g = vcu >> 3, hh = vcu & 7; float* PPf = (float*)(ws + WS_PP);
                chain<4>(PPf + ((size_t)(8 * g * 8 + hh) * 2) * 4096, (size_t)8 * 2 * 4096, 8, nullptr, nullptr, 0, (float*)(ws + WS_GPP) + ((size_t)(g * 8 + hh) * 2) * 4096, (LAS float*)ldsl, tid, wave, lane); }
        } else if (kind == 5) {
            if (vcu >= 8) wconv_mlp(a, layer, 0, wl, (vcu - 8) * NWAVES + wave, (G - 8) * NWAVES, lane);
            if (vcu < 8) { const int hh = vcu; float* PPf = (float*)(ws + WS_PP);
                chain<2>((const float*)(ws + WS_GPP) + ((size_t)hh * 2) * 4096, (size_t)8 * 2 * 4096, 16, nullptr, PPf + ((size_t)(7 * 8 + hh) * 2 + 1) * 4096, (size_t)64 * 2 * 4096, nullptr, (LAS float*)ldsl, tid, wave, lane); }
        } else if (kind == 11) {
            if (vcu >= 128) wconv_mlp(a, layer, 2, wl, (vcu - 128) * NWAVES + wave, (G - 128) * NWAVES, lane);
            if (vcu < 128) { const int g = vcu >> 3, hh = vcu & 7; float* PPf = (float*)(ws + WS_PP);
                chain<2>(PPf + ((size_t)(8 * g * 8 + hh) * 2) * 4096, (size_t)8 * 2 * 4096, 7, g ? PPf + ((size_t)((8 * g - 1) * 8 + hh) * 2 + 1) * 4096 : nullptr, PPf + ((size_t)(8 * g * 8 + hh) * 2 + 1) * 4096, (size_t)8 * 2 * 4096, nullptr, (LAS float*)ldsl, tid, wave, lane); }
        } else if (kind == 6) {
            scan_out((const bf16*)(ws + WS_REC), (const float*)(ws + WS_PP), (const bf16*)(ws + WS_PRQ), (const float*)(ws + WS_BON), INP(15) + j * 512, INP(16) + j * 512, (bf16*)(ws + WS_OZE), vcu, G, wave, lane);
        } else {
            combine_rows((const bf16*)(ws + WS_O0), (const bf16*)(ws + WS_O1), INP(21) + j * 256, INP(22) + j * 128, 0.8f - 0.6f * expf(-0.3f * (float)layer), (bf16*)(ws + WS_OZO), gw, NGW, lane);
        }
        }
        if ((rep == 1 || !((REP_MASK >> kind) & 1)) && p + 1 < a.ph_hi) {
            if (p == a.ph_lo) grid.sync();
            else xcd_barrier(xbar);
        }
    }
}

extern "C" void kernel_launch(void* const* d_in, const int* in_sizes, int n_in, void* d_out, int out_size, void* d_ws, size_t ws_size, hipStream_t stream) {
    static int grid = 0;
    if (grid == 0) {
        if (n_in != 24 || out_size != 16384 * 1024 || ws_size < WS_END) { fprintf(stderr, "kernel_launch: unexpected shapes: n_in %d out %d ws %zu; nothing launched\n", n_in, out_size, ws_size); grid = -1; return; }
        int dev = 0, cus = 0, per_cu = 0;
        if (hipGetDevice(&dev) != hipSuccess || hipDeviceGetAttribute(&cus, hipDeviceAttributeMultiprocessorCount, dev) != hipSuccess) { grid = -1; return; }
        if (hipFuncSetAttribute((const void*)mega_fwd, hipFuncAttributeMaxDynamicSharedMemorySize, LDS_BYTES) != hipSuccess) { fprintf(stderr, "kernel_launch: hipFuncSetAttribute failed\n"); grid = -1; return; }
        if (hipOccupancyMaxActiveBlocksPerMultiprocessor(&per_cu, (const void*)mega_fwd, NWAVES * 64, LDS_BYTES) != hipSuccess || per_cu < 1) { fprintf(stderr, "kernel_launch: occupancy query says %d blocks per CU\n", per_cu); per_cu = 1; }
        (void)hipGetLastError();
        grid = cus;
    }
    if (grid < 0) return;
    if (hipMemsetAsync(d_ws, 0, 16384, stream) != hipSuccess) { fprintf(stderr, "kernel_launch: hipMemsetAsync failed\n"); return; }
    Args a{};
    for (int i = 0; i < 24; ++i) a.in[i] = (const float*)d_in[i];
    a.out = (float*)d_out; a.ws = (unsigned char*)d_ws;
#if MK_SINGLE
    a.ph_lo = 0; a.ph_hi = NPH;
    void* args[] = {&a};
    hipError_t e = hipLaunchCooperativeKernel((const void*)mega_fwd, dim3(grid), dim3(NWAVES * 64), args, LDS_BYTES, stream);
    if (e != hipSuccess) fprintf(stderr, "kernel_launch: cooperative launch failed: %s (grid %d)\n", hipGetErrorString(e), grid);
#else
    for (int p = 0; p < NPH; ++p) { a.ph_lo = p; a.ph_hi = p + 1; hipLaunchKernelGGL(mega_fwd, dim3(grid), dim3(NWAVES * 64), LDS_BYTES, stream, a); }
#endif
}
```
